# Optimizing an MI355X kernel written in HIP

```python
import math
import jax, jax.numpy as jnp
from jax import lax
import numpy as np

D_MODEL = 1024
BATCH = 8
SEQ = 4096
DEPTH = 2

GRID_W = 64
CTX_LEN = 256
CHUNK = 64
EPS = 1e-6
A_HEADS = 4
A_DK = 128
A_DV = 128
A_WIDTH = A_HEADS * A_DK
B_HEADS = 4
B_DK = 128
B_DV = 128
B_WIDTH = B_HEADS * B_DV
B_CONV = 5
C_WIDTH = 512
C_GROUP = 16
C_GROUPS = C_WIDTH // C_GROUP
C_STATE = 64
N_BRANCH = 3
D_FF = 4 * D_MODEL
IN_SIZES = (A_WIDTH, A_HEADS * A_DV, 2 * A_WIDTH, A_HEADS * A_DV,
            2 * B_HEADS * B_DK + B_HEADS * B_DV, B_WIDTH, 2 * B_HEADS, 2 * B_HEADS,
            C_WIDTH, N_BRANCH * D_MODEL)
IN_SPLITS = tuple(int(s) for s in np.cumsum(IN_SIZES)[:-1])
D_IN = int(sum(IN_SIZES))

kernel_name = 'hybrid_hgrn2_gdn_s5_prefix_dit'


def _rmsnorm(x, w):
    xf = x.astype(jnp.float32)
    y = xf * lax.rsqrt(jnp.mean(xf * xf, axis=-1, keepdims=True) + EPS)
    return (y * w.astype(jnp.float32)).astype(x.dtype)


def _modulate(h, shift, scale):
    return h * (1.0 + scale) + shift


def _heads(a, n_heads):
    b, n, _ = a.shape
    return a.reshape(b, n, n_heads, -1).transpose(0, 2, 1, 3)


def _merge_heads(a):
    b, h, n, d = a.shape
    return a.transpose(0, 2, 1, 3).reshape(b, n, h * d)


def _l2norm(a):
    return a * lax.rsqrt(jnp.sum(a * a, axis=-1, keepdims=True) + EPS)


def _to_chunks(a):
    b, h, n = a.shape[:3]
    return jnp.moveaxis(a.reshape((b, h, n // CHUNK, CHUNK) + a.shape[3:]), 2, 0)


def _from_chunks(a):
    a = jnp.moveaxis(a, 0, 2)
    return a.reshape(a.shape[:2] + (-1,) + a.shape[4:])


def _gla_chunked(q, k, v, log_f, s0):
    incl = jnp.tril(jnp.ones((CHUNK, CHUNK), dtype=bool))

    def step(s, inp):
        qc, kc, vc, gc = inp
        cum = jnp.cumsum(gc, axis=2)
        diff = cum[:, :, :, None, :] - cum[:, :, None, :, :]
        decay = jnp.where(incl[:, :, None], jnp.exp(jnp.minimum(diff, 0.0)), 0.0)
        att = jnp.einsum('bhtd,bhsd,bhtsd->bhts', qc, kc, decay)
        o = (jnp.einsum('bhts,bhsv->bhtv', att, vc)
             + jnp.einsum('bhtd,bhdv->bhtv', qc * jnp.exp(cum), s))
        last = cum[:, :, -1:, :]
        s = (s * jnp.exp(last[:, :, 0, :, None])
             + jnp.einsum('bhsd,bhsv->bhdv', kc * jnp.exp(last - cum), vc))
        return s, o

    s_fin, o = lax.scan(step, s0, (_to_chunks(q), _to_chunks(k), _to_chunks(v), _to_chunks(log_f)))
    return _from_chunks(o), s_fin


def _delta_chunked(q, k, v, beta, log_a, s0):
    incl = jnp.tril(jnp.ones((CHUNK, CHUNK), dtype=bool))
    strict = jnp.tril(jnp.ones((CHUNK, CHUNK), dtype=bool), k=-1)
    eye = jnp.eye(CHUNK, dtype=jnp.float32)
    dv = v.shape[-1]

    def step(s, inp):
        qc, kc, vc, bc, gc = inp
        cum = jnp.cumsum(gc, axis=-1)
        dmask = jnp.where(incl, jnp.exp(jnp.minimum(cum[..., :, None] - cum[..., None, :], 0.0)), 0.0)
        kb = kc * bc[..., None]
        m = jnp.where(strict, -jnp.einsum('bhtd,bhsd->bhts', kb, kc) * dmask, 0.0)
        rhs = jnp.concatenate([vc * bc[..., None], kb * jnp.exp(cum)[..., None]], axis=-1)
        sol = lax.linalg.triangular_solve(eye - m, rhs, left_side=True, lower=True, unit_diagonal=True)
        u, w = sol[..., :dv], sol[..., dv:]
        v_new = u - jnp.einsum('bhtd,bhdv->bhtv', w, s)
        att = jnp.einsum('bhtd,bhsd->bhts', qc, kc) * dmask
        o = (jnp.einsum('bhtd,bhdv->bhtv', qc * jnp.exp(cum)[..., None], s)
             + jnp.einsum('bhts,bhsv->bhtv', att, v_new))
        last = cum[..., -1:]
        s = (s * jnp.exp(last)[..., None]
             + jnp.einsum('bhsd,bhsv->bhdv', kc * jnp.exp(last - cum)[..., None], v_new))
        return s, o

    s_fin, o = lax.scan(step, s0, (_to_chunks(q), _to_chunks(k), _to_chunks(v),
                                   _to_chunks(beta), _to_chunks(log_a)))
    return _from_chunks(o), s_fin


def _bidir_scan(run, ctx_f, ctx_b, lat_f, lat_b, s0):
    flip = lambda arrs: [jnp.flip(a, axis=2) for a in arrs]
    yc_f, sc_f = run(*ctx_f, s0)
    yc_b, sc_b = run(*flip(ctx_b), s0)
    yl_f, _ = run(*lat_f, sc_f)
    yl_b, _ = run(*flip(lat_b), sc_b)
    return yc_f + jnp.flip(yc_b, axis=2), yl_f + jnp.flip(yl_b, axis=2)


def _hgrn2_prepare(q, i, f2, lb):
    b, n, _ = q.shape
    qh = _heads(jax.nn.silu(q.astype(jnp.float32)), A_HEADS)
    vh = _heads(i.astype(jnp.float32), A_HEADS)
    z = jnp.moveaxis(f2.astype(jnp.float32).reshape(b, n, 2, A_WIDTH), 2, 0)
    lbb = lb[:, None, None, :]
    fval = lbb + (1.0 - lbb) * jax.nn.sigmoid(z)
    args = [(qh, _heads(1.0 - fval[d], A_HEADS), vh, _heads(jnp.log(fval[d]), A_HEADS)) for d in range(2)]
    return args[0], args[1]


def _short_conv(x, w):
    ch = x.shape[-1]
    return lax.conv_general_dilated(x, w[:, None, :].astype(x.dtype), window_strides=(1,),
                                    padding=[(B_CONV // 2, B_CONV // 2)],
                                    dimension_numbers=('NWC', 'WIO', 'NWC'), feature_group_count=ch)


def _gdn_prepare(qkv, beta2, a2, conv_w, a_log, dt_bias):
    b, n, _ = qkv.shape
    f32 = jnp.float32
    qkv = jax.nn.silu(_short_conv(qkv, conv_w)).astype(f32)
    q, k, v = jnp.split(qkv, [B_HEADS * B_DK, 2 * B_HEADS * B_DK], axis=-1)
    q = _l2norm(_heads(q, B_HEADS)) * (B_DK ** -0.5)
    k = _l2norm(_heads(k, B_HEADS))
    v = _heads(v, B_HEADS)
    beta = jax.nn.sigmoid(beta2.astype(f32)).reshape(b, n, 2, B_HEADS).transpose(2, 0, 3, 1)
    a = a2.astype(f32).reshape(b, n, 2, B_HEADS).transpose(2, 0, 3, 1)
    g = -jnp.exp(a_log.astype(f32))[:, None, :, None] * jax.nn.softplus(a + dt_bias.astype(f32)[:, None, :, None])
    return (q, k, v, beta[0], g[0]), (q, k, v, beta[1], g[1])


def _s5_discretize(lam_re, lam_im, log_dt, b_re, b_im):
    f32 = jnp.float32
    lr = jnp.minimum(lam_re.astype(f32), -1e-4)
    li = lam_im.astype(f32)
    dt = jnp.exp(log_dt.astype(f32))[:, None]
    mag = jnp.exp(lr * dt)
    ar, ai = mag * jnp.cos(li * dt), mag * jnp.sin(li * dt)
    den = lr * lr + li * li
    cr = ((ar - 1.0) * lr + ai * li) / den
    ci = (ai * lr - (ar - 1.0) * li) / den
    br, bi = b_re.astype(f32), b_im.astype(f32)
    bbr = cr[..., None] * br - ci[..., None] * bi
    bbi = cr[..., None] * bi + ci[..., None] * br
    return ar, ai, bbr, bbi


def _complex_affine_combine(e1, e2):
    a1r, a1i, b1r, b1i = e1
    a2r, a2i, b2r, b2i = e2
    return (a2r * a1r - a2i * a1i, a2r * a1i + a2i * a1r,
            a2r * b1r - a2i * b1i + b2r, a2r * b1i + a2i * b1r + b2i)


def _s5_scan(u, ar, ai, bbr, bbi, x0r, x0i):
    n = u.shape[1]
    bur = jnp.einsum('gsc,bngc->bngs', bbr, u)
    bui = jnp.einsum('gsc,bngc->bngs', bbi, u)
    bur = bur.at[:, 0].add(ar * x0r - ai * x0i)
    bui = bui.at[:, 0].add(ar * x0i + ai * x0r)
    a_r = jnp.broadcast_to(ar, (1, n) + ar.shape)
    a_i = jnp.broadcast_to(ai, (1, n) + ai.shape)
    _, _, xr, xi = lax.associative_scan(_complex_affine_combine, (a_r, a_i, bur, bui), axis=1)
    return xr, xi


def _s5_readout(xr, xi, c_re, c_im):
    f32 = jnp.float32
    y = (jnp.einsum('gcs,bngs->bngc', c_re.astype(f32), xr)
         - jnp.einsum('gcs,bngs->bngc', c_im.astype(f32), xi))
    return y.reshape(y.shape[0], y.shape[1], C_WIDTH)


def _s5_mixer(u_ctx, u_lat, rows, lam_re, lam_im, log_dt, b_re, b_im, c_re, c_im, d_skip):
    f32 = jnp.float32
    dt = u_lat.dtype
    bsz, n, _ = u_lat.shape
    uc = u_ctx.astype(f32)
    ul = u_lat.astype(f32).reshape(bsz, rows, GRID_W, C_WIDTH).transpose(0, 2, 1, 3).reshape(bsz, n, C_WIDTH)
    gc = uc.reshape(bsz, uc.shape[1], C_GROUPS, C_GROUP)
    gl = ul.reshape(bsz, n, C_GROUPS, C_GROUP)
    x0 = jnp.zeros((bsz, C_GROUPS, C_STATE), f32)
    disc_f = _s5_discretize(lam_re[0], lam_im[0], log_dt[0], b_re, b_im)
    disc_b = _s5_discretize(lam_re[1], lam_im[1], log_dt[1], b_re, b_im)
    cfr, cfi = _s5_scan(gc, *disc_f, x0, x0)
    cbr, cbi = _s5_scan(jnp.flip(gc, axis=1), *disc_b, x0, x0)
    lfr, lfi = _s5_scan(gl, *disc_f, cfr[:, -1], cfi[:, -1])
    lbr, lbi = _s5_scan(jnp.flip(gl, axis=1), *disc_b, cbr[:, -1], cbi[:, -1])
    d = d_skip.astype(f32)
    yc = (_s5_readout(cfr, cfi, c_re, c_im) + jnp.flip(_s5_readout(cbr, cbi, c_re, c_im), axis=1) + d * uc)
    yl = (_s5_readout(lfr, lfi, c_re, c_im) + jnp.flip(_s5_readout(lbr, lbi, c_re, c_im), axis=1) + d * ul)
    yl = yl.reshape(bsz, GRID_W, rows, C_WIDTH).transpose(0, 2, 1, 3).reshape(bsz, n, C_WIDTH)
    return yc.astype(dt), yl.astype(dt)


def _norm_gate(o, w, gate):
    return _merge_heads(_rmsnorm(o, w)) * jax.nn.silu(gate.astype(jnp.float32))


def _branch_merge(oa, ga, ob, zb, yc, gate_pre, hgrn_norm_w, gdn_norm_w, w_glu, w_ba, w_bb, w_bc, w_o):
    dt = gate_pre.dtype
    ya = _norm_gate(oa, hgrn_norm_w, ga).astype(dt) @ w_ba
    yb = _norm_gate(ob, gdn_norm_w, zb).astype(dt) @ w_bb
    z = jax.nn.gelu(yc)
    ycc = (z * jax.nn.sigmoid(z @ w_glu)) @ w_bc
    g_a, g_b, g_c = jnp.split(jax.nn.sigmoid(gate_pre.astype(jnp.float32)).astype(dt), N_BRANCH, axis=-1)
    return (g_a * ya + g_b * yb + g_c * ycc) @ w_o


def _sqrelu_mlp(h, w1, w2):
    return jnp.square(jax.nn.relu(h @ w1)) @ w2


def setup_inputs(seed: int = 0) -> dict:
    key = jax.random.key(seed)
    ks = iter(jax.random.split(key, 40))
    f32 = jnp.float32
    nrm = lambda shape, scale: jax.random.normal(next(ks), shape, f32) * scale
    unif = lambda shape, lo, hi: jax.random.uniform(next(ks), shape, f32, minval=lo, maxval=hi)
    d = D_MODEL
    dt_init = jnp.exp(unif((DEPTH, 2, B_HEADS), math.log(1e-3), math.log(1e-1)))
    return {
        'x': nrm((BATCH, SEQ, d), 1.0),
        'c': nrm((BATCH, d), 1.0),
        'ctx': nrm((BATCH, CTX_LEN, d), 1.0),
        'c_ctx': nrm((d,), 1.0),
        'ada_w': nrm((DEPTH, d, 6 * d), 0.5 * d ** -0.5),
        'ada_b': nrm((DEPTH, 6 * d), 0.02),
        'norm1_w': 1.0 + nrm((DEPTH, d), 0.02),
        'w_in': nrm((DEPTH, d, D_IN), d ** -0.5),
        'hgrn_lb_logits': nrm((DEPTH, 2, A_WIDTH), 0.5),
        'hgrn_norm_w': 1.0 + nrm((DEPTH, A_DV), 0.02),
        'gdn_conv_w': nrm((DEPTH, B_CONV, 2 * B_HEADS * B_DK + B_HEADS * B_DV), B_CONV ** -0.5),
        'gdn_a_log': jnp.log(unif((DEPTH, 2, B_HEADS), 1.0, 16.0)),
        'gdn_dt_bias': dt_init + jnp.log(-jnp.expm1(-dt_init)),
        'gdn_norm_w': 1.0 + nrm((DEPTH, B_DV), 0.02),
        's5_lam_re': -0.5 + nrm((DEPTH, 2, C_GROUPS, C_STATE), 0.01),
        's5_lam_im': jnp.pi * jnp.arange(C_STATE, dtype=f32) + nrm((DEPTH, 2, C_GROUPS, C_STATE), 0.01),
        's5_log_dt': unif((DEPTH, 2, C_GROUPS), math.log(1e-3), math.log(1e-1)),
        's5_b_re': nrm((DEPTH, C_GROUPS, C_STATE, C_GROUP), (2 * C_GROUP) ** -0.5),
        's5_b_im': nrm((DEPTH, C_GROUPS, C_STATE, C_GROUP), (2 * C_GROUP) ** -0.5),
        's5_c_re': nrm((DEPTH, C_GROUPS, C_GROUP, C_STATE), C_STATE ** -0.5),
        's5_c_im': nrm((DEPTH, C_GROUPS, C_GROUP, C_STATE), C_STATE ** -0.5),
        's5_d': nrm((DEPTH, C_WIDTH), 1.0),
        's5_w_glu': nrm((DEPTH, C_WIDTH, C_WIDTH), C_WIDTH ** -0.5),
        'w_branch_a': nrm((DEPTH, A_HEADS * A_DV, d), (A_HEADS * A_DV) ** -0.5),
        'w_branch_b': nrm((DEPTH, B_WIDTH, d), B_WIDTH ** -0.5),
        'w_branch_c': nrm((DEPTH, C_WIDTH, d), C_WIDTH ** -0.5),
        'w_out': nrm((DEPTH, d, d), d ** -0.5),
        'norm2_w': 1.0 + nrm((DEPTH, d), 0.02),
        'w_ff1': nrm((DEPTH, d, D_FF), d ** -0.5),
        'w_ff2': nrm((DEPTH, D_FF, d), D_FF ** -0.5),
        'final_norm_w': 1.0 + nrm((d,), 0.02),
    }


def reference(x, c, ctx, c_ctx, ada_w, ada_b, norm1_w, w_in, hgrn_lb_logits, hgrn_norm_w,
              gdn_conv_w, gdn_a_log, gdn_dt_bias, gdn_norm_w,
              s5_lam_re, s5_lam_im, s5_log_dt, s5_b_re, s5_b_im, s5_c_re, s5_c_im, s5_d, s5_w_glu,
              w_branch_a, w_branch_b, w_branch_c, w_out, norm2_w, w_ff1, w_ff2, final_norm_w):
    bsz, n, _ = x.shape
    rows = n // GRID_W
    lb_all = jnp.cumsum(jax.nn.softmax(hgrn_lb_logits.astype(jnp.float32), axis=0), axis=0)
    lb_all = lb_all - lb_all[0]
    s0_a = jnp.zeros((bsz, A_HEADS, A_DK, A_DV), jnp.float32)
    s0_b = jnp.zeros((bsz, B_HEADS, B_DK, B_DV), jnp.float32)
    xl, xc = x, ctx
    for l in range(DEPTH):
        last = l == DEPTH - 1
        ml = [m[:, None, :] for m in jnp.split(jax.nn.silu(c) @ ada_w[l] + ada_b[l], 6, axis=-1)]
        mc = jnp.split(jax.nn.silu(c_ctx) @ ada_w[l] + ada_b[l], 6, axis=-1)
        pl = jnp.split(_modulate(_rmsnorm(xl, norm1_w[l]), ml[0], ml[1]) @ w_in[l], IN_SPLITS, axis=-1)
        pc = jnp.split(_modulate(_rmsnorm(xc, norm1_w[l]), mc[0], mc[1]) @ w_in[l], IN_SPLITS, axis=-1)
        a_cf, a_cb = _hgrn2_prepare(pc[0], pc[1], pc[2], lb_all[l])
        a_lf, a_lb = _hgrn2_prepare(pl[0], pl[1], pl[2], lb_all[l])
        oa_c, oa_l = _bidir_scan(_gla_chunked, a_cf, a_cb, a_lf, a_lb, s0_a)
        b_cf, b_cb = _gdn_prepare(pc[4], pc[6], pc[7], gdn_conv_w[l], gdn_a_log[l], gdn_dt_bias[l])
        b_lf, b_lb = _gdn_prepare(pl[4], pl[6], pl[7], gdn_conv_w[l], gdn_a_log[l], gdn_dt_bias[l])
        ob_c, ob_l = _bidir_scan(_delta_chunked, b_cf, b_cb, b_lf, b_lb, s0_b)
        yc_c, yc_l = _s5_mixer(pc[8], pl[8], rows, s5_lam_re[l], s5_lam_im[l], s5_log_dt[l],
                               s5_b_re[l], s5_b_im[l], s5_c_re[l], s5_c_im[l], s5_d[l])
        br = (hgrn_norm_w[l], gdn_norm_w[l], s5_w_glu[l], w_branch_a[l], w_branch_b[l], w_branch_c[l], w_out[l])
        xl = xl + ml[2] * _branch_merge(oa_l, pl[3], ob_l, pl[5], yc_l, pl[9], *br)
        xl = xl + ml[5] * _sqrelu_mlp(_modulate(_rmsnorm(xl, norm2_w[l]), ml[3], ml[4]), w_ff1[l], w_ff2[l])
        if not last:
            xc = xc + mc[2] * _branch_merge(oa_c, pc[3], ob_c, pc[5], yc_c, pc[9], *br)
            xc = xc + mc[5] * _sqrelu_mlp(_modulate(_rmsnorm(xc, norm2_w[l]), mc[3], mc[4]), w_ff1[l], w_ff2[l])
    return _rmsnorm(xl, final_norm_w)
```

```cpp
#include <hip/hip_runtime.h>
#include <hip/hip_cooperative_groups.h>
#include <cstdio>
namespace cg = cooperative_groups;

typedef unsigned short u16;
typedef __attribute__((ext_vector_type(8))) short bf16x8;
typedef __attribute__((ext_vector_type(4))) float f32x4;
typedef __attribute__((ext_vector_type(4))) unsigned int u32x4;

#ifndef COOP
#define COOP 1
#endif

#define NT 512
#define MLAT 32768
#define MALL 34816
#define LDS_BYTES 131072

constexpr size_t SZ_WT   = 19791872ull * 2;
constexpr size_t OFF_WT  = 0;
constexpr size_t OFF_H   = OFF_WT + SZ_WT;
constexpr size_t SZ_H    = 34816ull * 1024 * 2;
constexpr size_t SZ_N    = 34816ull * 512 * 2;
constexpr size_t OFF_NA  = OFF_H + SZ_H;
constexpr size_t OFF_NB  = OFF_NA + SZ_N;
constexpr size_t OFF_GL  = OFF_NB + SZ_N;
constexpr size_t OFF_XC  = OFF_GL + SZ_N;
constexpr size_t OFF_MODS = OFF_XC + 2048ull * 1024 * 4;
constexpr size_t OFF_LB  = OFF_MODS + 442368;
constexpr size_t OFF_KT  = OFF_LB + 8192;
constexpr size_t OFF_BA  = OFF_KT + 4194304;
constexpr size_t OFF_R   = OFF_BA + 34816ull * 16 * 4;
constexpr size_t R_PA = 0;
constexpr size_t R_OF = 34816ull * 2560 * 2;
constexpr size_t R_OB = R_OF + SZ_N;
constexpr size_t R_PB = 0;
constexpr size_t R_QKV = 34816ull * 2176 * 2;
constexpr size_t R_UG = 0;
constexpr size_t R_BP = 32ull * 768 * 1280 * 2;
constexpr size_t R_M1 = R_BP + 32ull * 1024 * 1280 * 2;
constexpr size_t R_DS = R_M1 + 64ull * 128 * 1024 * 2;
constexpr size_t R_ZC = 240000000ull;
constexpr size_t R_PG = 0;
constexpr size_t R_HID = 0;
constexpr size_t W_IN = 0, W_FF1 = 8519680, W_FF2 = 12713984, W_O = 16908288, W_BA = 17956864,
                 W_BB = 18481152, W_BC = 19005440, W_GLU = 19529728;

struct P {
  const float* in[31];
  float* out;
  char* ws;
};

__device__ __forceinline__ int TID() { int t = threadIdx.x; asm volatile("" : "+v"(t)); return t; }
template <class T> __device__ __forceinline__ T* lptr(T* q) { asm volatile("" : "+s"(q)); return q; }

__device__ __forceinline__ u16 f2bf(float f) {
  unsigned u = __float_as_uint(f);
  u += 0x7fffu + ((u >> 16) & 1u);
  return (u16)(u >> 16);
}
__device__ __forceinline__ float bf2f(u16 h) { return __uint_as_float(((unsigned)h) << 16); }
__device__ __forceinline__ unsigned pack2(float a, float b) { return (unsigned)f2bf(a) | ((unsigned)f2bf(b) << 16); }
__device__ __forceinline__ uint2 pack4(f32x4 v) { uint2 r; r.x = pack2(v[0], v[1]); r.y = pack2(v[2], v[3]); return r; }
__device__ __forceinline__ float wsum(float v) {
#pragma unroll
  for (int o = 32; o > 0; o >>= 1) v += __shfl_xor(v, o, 64);
  return v;
}
__device__ __forceinline__ float sigm(float x) { return 1.f / (1.f + __expf(-x)); }
__device__ __forceinline__ float siluf(float x) { return x / (1.f + __expf(-x)); }
__device__ __forceinline__ float geluf(float x) {
  float u = 0.7978845608028654f * (x + 0.044715f * x * x * x);
  return 0.5f * x * (1.f + tanhf(u));
}
__device__ __forceinline__ bf16x8 ldfrag(const u16* base, int row, int stride, int koff) {
  return *(const bf16x8*)(base + row * stride + koff);
}
#define MFMA(a, b, c) __builtin_amdgcn_mfma_f32_16x16x32_bf16(a, b, c, 0, 0, 0)

__device__ __forceinline__ int chain_row(int b, int dir, int c, int tau) {
  if (dir == 0) {
    if (c < 4) return MLAT + b * 256 + c * 64 + tau;
    return b * 4096 + (c - 4) * 64 + tau;
  } else {
    if (c < 4) return MLAT + b * 256 + (3 - c) * 64 + 63 - tau;
    return b * 4096 + (67 - c) * 64 + 63 - tau;
  }
}

__device__ __forceinline__ void gemm_loop(const u16* __restrict__ A, long lda, const u16* __restrict__ W, long ldw,
                                          int K, char* smem, f32x4 (&acc)[4][4]) {
  const int t = TID(), lane = t & 63, w = t >> 6, wm = w & 3, wn = w >> 2;
  const int lr = t >> 3, kc = (t & 7) * 8;
  u16* sA = (u16*)smem;
  u16* sW = sA + 256 * 72;
  const u16* ga = A + (long)lr * lda + kc;
  const u16* gw = W + (long)lr * ldw + kc;
  u32x4 ra[4], rw[2];
#pragma unroll
  for (int i = 0; i < 4; ++i) ra[i] = *(const u32x4*)(ga + (long)(64 * i) * lda);
#pragma unroll
  for (int i = 0; i < 2; ++i) rw[i] = *(const u32x4*)(gw + (long)(64 * i) * ldw);
  const int fr = lane & 15, fq = (lane >> 4) * 8;
  for (int k0 = 0; k0 < K; k0 += 64) {
    __syncthreads();
#pragma unroll
    for (int i = 0; i < 4; ++i) *(u32x4*)(sA + (lr + 64 * i) * 72 + kc) = ra[i];
#pragma unroll
    for (int i = 0; i < 2; ++i) *(u32x4*)(sW + (lr + 64 * i) * 72 + kc) = rw[i];
    __syncthreads();
    if (k0 + 64 < K) {
#pragma unroll
      for (int i = 0; i < 4; ++i) ra[i] = *(const u32x4*)(ga + (long)(64 * i) * lda + k0 + 64);
#pragma unroll
      for (int i = 0; i < 2; ++i) rw[i] = *(const u32x4*)(gw + (long)(64 * i) * ldw + k0 + 64);
    }
#pragma unroll
    for (int ks = 0; ks < 2; ++ks) {
      bf16x8 fa[4], fw[4];
#pragma unroll
      for (int i = 0; i < 4; ++i) fw[i] = ldfrag(sW, wn * 64 + i * 16 + fr, 72, ks * 32 + fq);
#pragma unroll
      for (int j = 0; j < 4; ++j) fa[j] = ldfrag(sA, wm * 64 + j * 16 + fr, 72, ks * 32 + fq);
#pragma unroll
      for (int i = 0; i < 4; ++i)
#pragma unroll
        for (int j = 0; j < 4; ++j) acc[i][j] = MFMA(fw[i], fa[j], acc[i][j]);
    }
  }
}
__device__ __forceinline__ void zero_acc(f32x4 (&acc)[4][4]) {
#pragma unroll
  for (int i = 0; i < 4; ++i)
#pragma unroll
    for (int j = 0; j < 4; ++j) acc[i][j] = f32x4{0.f, 0.f, 0.f, 0.f};
}
#define EPI_LOOP(...)                                                         \
  {                                                                           \
    const int _t = TID(), _lane = _t & 63, _w = _t >> 6;                \
    const int _wm = _w & 3, _wn = _w >> 2;                                    \
    _Pragma("unroll") for (int _i = 0; _i < 4; ++_i)                          \
    _Pragma("unroll") for (int _j = 0; _j < 4; ++_j) {                        \
      const int ml = _wm * 64 + _j * 16 + (_lane & 15);                       \
      const int nl = _wn * 64 + _i * 16 + (_lane >> 4) * 4;                   \
      f32x4 v = acc[_i][_j];                                                  \
      __VA_ARGS__                                                             \
    }                                                                         \
  }

__device__ __forceinline__ int mod_idx(int r) { return r < MLAT ? (r >> 12) : 8; }

struct S5c { double lr, li, dt; };
__device__ __forceinline__ S5c s5_load(const P& p, int l, int dir, int g, int s) {
  S5c c;
  float lre = lptr(p.in[14])[((l * 2 + dir) * 32 + g) * 64 + s];
  c.lr = (double)fminf(lre, -1e-4f);
  c.li = (double)lptr(p.in[15])[((l * 2 + dir) * 32 + g) * 64 + s];
  c.dt = exp((double)lptr(p.in[16])[(l * 2 + dir) * 32 + g]);
  return c;
}
__device__ __forceinline__ void s5_pow(const S5c& c, int j, double& re, double& im) {
  double mag = exp(c.lr * c.dt * (double)j);
  double ang = c.li * c.dt * (double)j;
  const double TWO_PI = 6.283185307179586476925286766559;
  ang -= TWO_PI * rint(ang / TWO_PI);
  re = mag * cos(ang);
  im = mag * sin(ang);
}
__device__ __forceinline__ void s5_coef(const S5c& c, double& cr, double& ci) {
  double ar, ai;
  s5_pow(c, 1, ar, ai);
  double den = c.lr * c.lr + c.li * c.li;
  cr = ((ar - 1.0) * c.lr + ai * c.li) / den;
  ci = (ai * c.lr - (ar - 1.0) * c.li) / den;
}


__device__ void ph_init(const P& p, int item, char* smem) {
  const int t = TID();
  if (item < 192) {
    const int l = item / 96, nb = item % 96;
    float* sc = (float*)smem;
    float* part = sc + 9 * 1024;
    __syncthreads();
    for (int e = t; e < 9 * 1024; e += NT) {
      int r = e >> 10, k = e & 1023;
      float cv = r < 8 ? lptr(p.in[1])[r * 1024 + k] : lptr(p.in[3])[k];
      sc[e] = siluf(cv);
    }
    __syncthreads();
    const int col = t & 63, kg = t >> 6;
    const float* wp = lptr(p.in[4]) + (size_t)l * 1024 * 6144 + nb * 64 + col;
    float a[9];
#pragma unroll
    for (int r = 0; r < 9; ++r) a[r] = 0.f;
    for (int k = kg * 128; k < kg * 128 + 128; ++k) {
      float wv = wp[(size_t)k * 6144];
#pragma unroll
      for (int r = 0; r < 9; ++r) a[r] += sc[r * 1024 + k] * wv;
    }
#pragma unroll
    for (int r = 0; r < 9; ++r) part[(kg * 9 + r) * 64 + col] = a[r];
    __syncthreads();
    float* mods = (float*)(lptr(p.ws) + OFF_MODS);
    for (int e = t; e < 9 * 64; e += NT) {
      int r = e >> 6, c2 = e & 63;
      float s = 0.f;
      for (int g2 = 0; g2 < 8; ++g2) s += part[(g2 * 9 + r) * 64 + c2];
      int n = nb * 64 + c2;
      mods[(l * 9 + r) * 6144 + n] = s + lptr(p.in[5])[l * 6144 + n];
    }
  } else if (item < 448) {
    const int it = item - 192;
    const float4* src = (const float4*)lptr(p.in[2]);
    float4* dst = (float4*)(lptr(p.ws) + OFF_XC);
#pragma unroll
    for (int i = 0; i < 4; ++i) dst[(size_t)it * 2048 + i * 512 + t] = src[(size_t)it * 2048 + i * 512 + t];
  } else {
    float* lb = (float*)(lptr(p.ws) + OFF_LB);
    for (int e = t; e < 1024; e += NT) {
      float l0 = lptr(p.in[8])[e], l1 = lptr(p.in[8])[1024 + e];
      float m = fmaxf(l0, l1);
      float e0 = expf(l0 - m), e1 = expf(l1 - m);
      lb[e] = 0.f;
      lb[1024 + e] = e1 / (e0 + e1);
    }
  }
}

__device__ void transpose_tile(const float* __restrict__ src, int Nsrc, u16* __restrict__ dst, int K, int tn, int tk,
                               bool win_map, char* smem) {
  float* tile = (float*)smem;
  const int t = TID(), tx = t & 63, ty = t >> 6;
  __syncthreads();
  int np = tn * 64 + tx;
  int sc = np;
  bool zero = false;
  if (win_map) {
    if (np >= 4736) sc = np - 112;
    else if (np >= 4624) zero = true;
  }
#pragma unroll
  for (int i = 0; i < 8; ++i) {
    int kk = ty + 8 * i;
    float v = zero ? 0.f : src[(size_t)(tk * 64 + kk) * Nsrc + sc];
    tile[tx * 65 + kk] = v;
  }
  __syncthreads();
#pragma unroll
  for (int i = 0; i < 8; ++i) {
    int nn = ty + 8 * i;
    dst[(size_t)(tn * 64 + nn) * K + tk * 64 + tx] = f2bf(tile[nn * 65 + tx]);
  }
}

__device__ void norm_rows(const P& p, int l, int item, int which) {
  const int t = TID(), lane = t & 63, w = t >> 6;
  const int r = item * 8 + w;
  const float* xr;
  if (r < MLAT) xr = ((which == 0 && l == 0) ? lptr(p.in[0]) : lptr(p.out)) + (size_t)r * 1024;
  else xr = (const float*)(lptr(p.ws) + OFF_XC) + (size_t)(r - MLAT) * 1024;
  const float* nw = (which == 0 ? lptr(p.in[6]) : lptr(p.in[27])) + l * 1024;
  const float* mods = (const float*)(lptr(p.ws) + OFF_MODS) + (size_t)(l * 9 + mod_idx(r)) * 6144;
  const float* sh = mods + (which == 0 ? 0 : 3) * 1024;
  const float* scl = mods + (which == 0 ? 1 : 4) * 1024;
  float4 v[4];
  float ss = 0.f;
#pragma unroll
  for (int i = 0; i < 4; ++i) {
    v[i] = *(const float4*)(xr + i * 256 + lane * 4);
    ss += v[i].x * v[i].x + v[i].y * v[i].y + v[i].z * v[i].z + v[i].w * v[i].w;
  }
  ss = wsum(ss);
  float rstd = rsqrtf(ss * (1.f / 1024.f) + 1e-6f);
  u16* H = (u16*)(lptr(p.ws) + OFF_H) + (size_t)r * 1024;
#pragma unroll
  for (int i = 0; i < 4; ++i) {
    int c = i * 256 + lane * 4;
    float4 wv = *(const float4*)(nw + c), s1 = *(const float4*)(sh + c), s2 = *(const float4*)(scl + c);
    f32x4 o;
    o[0] = v[i].x * rstd * wv.x * (1.f + s2.x) + s1.x;
    o[1] = v[i].y * rstd * wv.y * (1.f + s2.y) + s1.y;
    o[2] = v[i].z * rstd * wv.z * (1.f + s2.z) + s1.z;
    o[3] = v[i].w * rstd * wv.w * (1.f + s2.w) + s1.w;
    *(uint2*)(H + c) = pack4(o);
  }
}

__device__ void s5_ktable(const P& p, int l, int item, char* smem) {
  const int t = TID();
  const int j = item & 63, g = (item >> 6) & 31, dir = item >> 11;
  float2* pwB = (float2*)smem;
  float2* Cc = pwB + 1024;
  double2* pc = (double2*)(smem + 32768);
  __syncthreads();
  if (t < 64) {
    S5c c = s5_load(p, l, dir, g, t);
    double pr, pi, cr, ci;
    s5_pow(c, j, pr, pi);
    s5_coef(c, cr, ci);
    pc[t] = double2{pr * cr - pi * ci, pr * ci + pi * cr};
  }
  __syncthreads();
  for (int e = t; e < 1024; e += NT) {
    int s = e >> 4, c2 = e & 15;
    double br = lptr(p.in[17])[((size_t)(l * 32 + g) * 64 + s) * 16 + c2];
    double bi = lptr(p.in[18])[((size_t)(l * 32 + g) * 64 + s) * 16 + c2];
    double2 q = pc[s];
    pwB[e] = float2{(float)(q.x * br - q.y * bi), (float)(q.x * bi + q.y * br)};
    int co = e >> 6, s2 = e & 63;
    Cc[e] = float2{lptr(p.in[19])[((size_t)(l * 32 + g) * 16 + co) * 64 + s2], lptr(p.in[20])[((size_t)(l * 32 + g) * 16 + co) * 64 + s2]};
  }
  __syncthreads();
  if (t < 256) {
    int co = t >> 4, ci2 = t & 15;
    float acc = 0.f;
    for (int s = 0; s < 64; ++s) {
      float2 c = Cc[co * 64 + s], b = pwB[s * 16 + ci2];
      acc += c.x * b.x - c.y * b.y;
    }
    float* KT = (float*)(lptr(p.ws) + OFF_KT);
    KT[((size_t)((dir * 32 + g) * 64 + j)) * 256 + t] = acc;
  }
}

__device__ void ph_start(const P& p, int l, int item, char* smem) {
  u16* WT = (u16*)(lptr(p.ws) + OFF_WT);
  if (item < 4832) {
    int it = item;
    if (it < 2080) { transpose_tile(lptr(p.in[7]) + (size_t)l * 1024 * 8208, 8208, WT + W_IN, 1024, it / 16, it % 16, true, smem); return; }
    it -= 2080;
    if (it < 1024) { transpose_tile(lptr(p.in[28]) + (size_t)l * 1024 * 4096, 4096, WT + W_FF1, 1024, it / 16, it % 16, false, smem); return; }
    it -= 1024;
    if (it < 1024) { transpose_tile(lptr(p.in[29]) + (size_t)l * 4096 * 1024, 1024, WT + W_FF2, 4096, it / 64, it % 64, false, smem); return; }
    it -= 1024;
    if (it < 256) { transpose_tile(lptr(p.in[26]) + (size_t)l * 1024 * 1024, 1024, WT + W_O, 1024, it / 16, it % 16, false, smem); return; }
    it -= 256;
    if (it < 384) {
      int which = it / 128, ii = it % 128;
      const float* src = lptr(p.in[23 + which]) + (size_t)l * 512 * 1024;
      transpose_tile(src, 1024, WT + W_BA + (size_t)which * 524288, 512, ii / 8, ii % 8, false, smem);
      return;
    }
    it -= 384;
    transpose_tile(lptr(p.in[22]) + (size_t)l * 512 * 512, 512, WT + W_GLU, 512, it / 8, it % 8, false, smem);
    return;
  }
  item -= 4832;
  if (item < 4352) { norm_rows(p, l, item, 0); return; }
  item -= 4352;
  s5_ktable(p, l, item, smem);
}

__device__ void gemm_simple(const P& p, int mode, int tile, char* smem) {
  const u16* H = (const u16*)(lptr(p.ws) + OFF_H);
  const u16* WT = (const u16*)(lptr(p.ws) + OFF_WT);
  char* R = lptr(p.ws) + OFF_R;
  int ntn, wrow0;
  const u16* W;
  if (mode == 0) { ntn = 20; W = WT + W_IN; wrow0 = 0; }
  else if (mode == 1) { ntn = 17; W = WT + W_IN; wrow0 = 2560; }
  else if (mode == 2) { ntn = 4; W = WT + W_IN; wrow0 = 4736; }
  else if (mode == 3) { ntn = 24; W = WT + W_IN; wrow0 = 5248; }
  else { ntn = 32; W = WT + W_FF1; wrow0 = 0; }
  const int tm = tile / ntn, tn = tile % ntn;
  const int m0 = tm * 256, n0 = tn * 128;
  f32x4 acc[4][4];
  zero_acc(acc);
  gemm_loop(H + (size_t)m0 * 1024, 1024, W + (size_t)(wrow0 + n0) * 1024, 1024, 1024, smem, acc);
  if (mode == 0) {
    u16* C = (u16*)(R + R_PA);
    EPI_LOOP({ *(uint2*)(C + (size_t)(m0 + ml) * 2560 + n0 + nl) = pack4(v); })
  } else if (mode == 1) {
    u16* C = (u16*)(R + R_PB);
    float* BA = (float*)(lptr(p.ws) + OFF_BA);
    EPI_LOOP({
      *(uint2*)(C + (size_t)(m0 + ml) * 2176 + n0 + nl) = pack4(v);
      if (tn == 16 && nl < 16) *(float4*)(BA + (size_t)(m0 + ml) * 16 + nl) = float4{v[0], v[1], v[2], v[3]};
    })
  } else if (mode == 2) {
    u16* UG = (u16*)(R + R_UG);
    EPI_LOOP({
      int m = m0 + ml, n = n0 + nl;
      int chunk, tau;
      if (m < MLAT) { int b = m >> 12, tt = m & 4095; chunk = b * 68 + 4 + (tt & 63); tau = tt >> 6; }
      else { int mm = m - MLAT; int b = mm >> 8, jj = mm & 255; chunk = b * 68 + (jj >> 6); tau = jj & 63; }
      int g = n >> 4, ci = n & 15;
      *(uint2*)(UG + ((size_t)(g * 768 + chunk)) * 1280 + tau * 16 + ci) = pack4(v);
    })
  } else if (mode == 3) {
    u16* C = (u16*)(R + R_PG);
    EPI_LOOP({
      f32x4 s; s[0] = sigm(v[0]); s[1] = sigm(v[1]); s[2] = sigm(v[2]); s[3] = sigm(v[3]);
      *(uint2*)(C + (size_t)(m0 + ml) * 3072 + n0 + nl) = pack4(s);
    })
  } else {
    u16* C = (u16*)(R + R_HID);
    EPI_LOOP({
      f32x4 s;
      _Pragma("unroll") for (int r = 0; r < 4; ++r) { float x = fmaxf(v[r], 0.f); s[r] = x * x; }
      *(uint2*)(C + (size_t)(m0 + ml) * 4096 + n0 + nl) = pack4(s);
    })
  }
}

__device__ void chain_a(const P& p, int l, int item, char* smem) {
  const int t = TID(), lane = t & 63, w = t >> 6;
  const int vs = item & 3, dir = (item >> 2) & 1, h = (item >> 3) & 3, b = item >> 5;
  u16* qh = (u16*)smem;
  u16* kh = qh + 64 * 136;
  u16* khT = kh + 64 * 136;
  u16* vT = khT + 128 * 72;
  u16* at = vT + 32 * 72;
  u16* sT = at + 64 * 72;
  float* tot = (float*)(sT + 32 * 136);
  float* c31 = tot + 512;
  float* lst = c31 + 128;
  const u16* PA = (const u16*)(lptr(p.ws) + OFF_R + R_PA);
  u16* OUT = (u16*)(lptr(p.ws) + OFF_R + (dir == 0 ? R_OF : R_OB));
  const float* lbp = (const float*)(lptr(p.ws) + OFF_LB) + (l * 2 + dir) * 512 + h * 128;
  const int d = t & 127, qtr = t >> 7;
  const float lbv = lbp[d];
  const int fr = lane & 15, fq = lane >> 4;
  f32x4 S[2];
  S[0] = f32x4{0.f, 0.f, 0.f, 0.f};
  S[1] = S[0];
  for (int c = 0; c < 68; ++c) {
    float cum[16], qv[16], kv[16];
    __syncthreads();
    {
      float run = 0.f;
#pragma unroll
      for (int i = 0; i < 16; ++i) {
        int row = chain_row(b, dir, c, qtr * 16 + i);
        const u16* pr = PA + (size_t)row * 2560;
        float z = bf2f(pr[1024 + dir * 512 + h * 128 + d]);
        float f = lbv + (1.f - lbv) * sigm(z);
        run += __logf(f);
        cum[i] = run;
        kv[i] = 1.f - f;
        qv[i] = siluf(bf2f(pr[h * 128 + d]));
      }
      tot[qtr * 128 + d] = run;
    }
    {
      int sg = t >> 3, v4 = (t & 7) * 4;
      int row = chain_row(b, dir, c, sg);
      uint2 raw = *(const uint2*)(PA + (size_t)row * 2560 + 512 + h * 128 + vs * 32 + v4);
      vT[(v4 + 0) * 72 + sg] = (u16)(raw.x & 0xffff);
      vT[(v4 + 1) * 72 + sg] = (u16)(raw.x >> 16);
      vT[(v4 + 2) * 72 + sg] = (u16)(raw.y & 0xffff);
      vT[(v4 + 3) * 72 + sg] = (u16)(raw.y >> 16);
    }
    __syncthreads();
    {
      float off = 0.f;
      for (int q2 = 0; q2 < qtr; ++q2) off += tot[q2 * 128 + d];
#pragma unroll
      for (int i = 0; i < 16; ++i) cum[i] += off;
      if (qtr == 1) c31[d] = cum[15];
      if (qtr == 3) lst[d] = cum[15];
    }
    __syncthreads();
    {
      float cm = c31[d];
#pragma unroll
      for (int i = 0; i < 16; ++i) {
        int tau = qtr * 16 + i;
        float e1 = __expf(cum[i] - cm);
        float e2 = __expf(cm - cum[i]);
        qh[tau * 136 + d] = f2bf(qv[i] * e1);
        u16 kb = f2bf(kv[i] * e2);
        kh[tau * 136 + d] = kb;
        khT[d * 72 + tau] = kb;
      }
#pragma unroll
      for (int vt = 0; vt < 2; ++vt) {
        int dd = w * 16 + fq * 4;
        f32x4 sv;
#pragma unroll
        for (int r = 0; r < 4; ++r) sv[r] = S[vt][r] * __expf(c31[dd + r]);
        *(uint2*)(sT + (vt * 16 + fr) * 136 + dd) = pack4(sv);
      }
    }
    __syncthreads();
    {
      int tt = w >> 1;
#pragma unroll
      for (int u = 0; u < 2; ++u) {
        int st = (w & 1) * 2 + u;
        f32x4 a = f32x4{0.f, 0.f, 0.f, 0.f};
        if (st <= tt) {
#pragma unroll
          for (int ks = 0; ks < 4; ++ks)
            a = MFMA(ldfrag(kh, st * 16 + fr, 136, ks * 32 + fq * 8), ldfrag(qh, tt * 16 + fr, 136, ks * 32 + fq * 8), a);
          int tau = tt * 16 + fr;
#pragma unroll
          for (int r = 0; r < 4; ++r) {
            int sg = st * 16 + fq * 4 + r;
            if (sg > tau) a[r] = 0.f;
          }
        }
        *(uint2*)(at + (tt * 16 + fr) * 72 + st * 16 + fq * 4) = pack4(a);
      }
    }
    __syncthreads();
    {
      int vt = w & 1, tt = w >> 1;
      f32x4 a = f32x4{0.f, 0.f, 0.f, 0.f};
#pragma unroll
      for (int ks = 0; ks < 4; ++ks)
        a = MFMA(ldfrag(sT, vt * 16 + fr, 136, ks * 32 + fq * 8), ldfrag(qh, tt * 16 + fr, 136, ks * 32 + fq * 8), a);
#pragma unroll
      for (int ks = 0; ks < 2; ++ks)
        a = MFMA(ldfrag(vT, vt * 16 + fr, 72, ks * 32 + fq * 8), ldfrag(at, tt * 16 + fr, 72, ks * 32 + fq * 8), a);
      int row = chain_row(b, dir, c, tt * 16 + fr);
      *(uint2*)(OUT + (size_t)row * 512 + h * 128 + vs * 32 + vt * 16 + fq * 4) = pack4(a);
#pragma unroll
      for (int v2 = 0; v2 < 2; ++v2) {
        f32x4 ds = f32x4{0.f, 0.f, 0.f, 0.f};
#pragma unroll
        for (int ks = 0; ks < 2; ++ks)
          ds = MFMA(ldfrag(khT, w * 16 + fr, 72, ks * 32 + fq * 8), ldfrag(vT, v2 * 16 + fr, 72, ks * 32 + fq * 8), ds);
#pragma unroll
        for (int r = 0; r < 4; ++r) {
          int dd = w * 16 + fq * 4 + r;
          float la = lst[dd], cm = c31[dd];
          S[v2][r] = __expf(la) * S[v2][r] + __expf(la - cm) * ds[r];
        }
      }
    }
  }
}

__device__ void normgate(const P& p, int l, int item, int which) {
  const int t = TID(), lane = t & 63, w = t >> 6;
  const int u = item * 8 + w;
  const int row = u >> 2, h = u & 3;
  const u16 *of, *ob, *gt;
  const float* nw;
  u16* out;
  char* R = lptr(p.ws) + OFF_R;
  if (which == 0) {
    of = (const u16*)(R + R_OF) + (size_t)row * 512;
    ob = (const u16*)(R + R_OB) + (size_t)row * 512;
    gt = (const u16*)(R + R_PA) + (size_t)row * 2560 + 2048;
    nw = lptr(p.in[9]) + l * 128;
    out = (u16*)(lptr(p.ws) + OFF_NA) + (size_t)row * 512;
  } else {
    of = (const u16*)(R + R_PB) + (size_t)row * 2176 + 512;
    ob = (const u16*)(R + R_PB) + (size_t)row * 2176 + 1024;
    gt = (const u16*)(R + R_PB) + (size_t)row * 2176 + 1536;
    nw = lptr(p.in[13]) + l * 128;
    out = (u16*)(lptr(p.ws) + OFF_NB) + (size_t)row * 512;
  }
  int c = h * 128 + lane * 2;
  unsigned a = *(const unsigned*)(of + c), bb = *(const unsigned*)(ob + c), g = *(const unsigned*)(gt + c);
  float o0 = bf2f((u16)(a & 0xffff)) + bf2f((u16)(bb & 0xffff));
  float o1 = bf2f((u16)(a >> 16)) + bf2f((u16)(bb >> 16));
  float ss = wsum(o0 * o0 + o1 * o1);
  float rstd = rsqrtf(ss * (1.f / 128.f) + 1e-6f);
  float g0 = bf2f((u16)(g & 0xffff)), g1 = bf2f((u16)(g >> 16));
  float y0 = o0 * rstd * nw[lane * 2] * siluf(g0);
  float y1 = o1 * rstd * nw[lane * 2 + 1] * siluf(g1);
  *(unsigned*)(out + c) = pack2(y0, y1);
}

__device__ void conv_b(const P& p, int l, int item) {
  const int t = TID(), lane = t & 63, w = t >> 6;
  const int u = item * 8 + w;
  const int row = u / 12, slot = u % 12;
  const u16* PB = (const u16*)(lptr(p.ws) + OFF_R + R_PB);
  u16* Q = (u16*)(lptr(p.ws) + OFF_R + R_QKV);
  int pos, len;
  if (row < MLAT) { pos = row & 4095; len = 4096; }
  else { pos = (row - MLAT) & 255; len = 256; }
  const int ch = slot * 128 + lane * 2;
  const float* cw = lptr(p.in[10]) + (size_t)l * 5 * 1536;
  float a0 = 0.f, a1 = 0.f;
#pragma unroll
  for (int j = 0; j < 5; ++j) {
    int pp = pos + j - 2;
    if (pp >= 0 && pp < len) {
      unsigned raw = *(const unsigned*)(PB + (size_t)(row + j - 2) * 2176 + ch);
      a0 += cw[j * 1536 + ch] * bf2f((u16)(raw & 0xffff));
      a1 += cw[j * 1536 + ch + 1] * bf2f((u16)(raw >> 16));
    }
  }
  a0 = siluf(a0);
  a1 = siluf(a1);
  if (slot < 8) {
    float ss = wsum(a0 * a0 + a1 * a1);
    float sc = rsqrtf(ss + 1e-6f);
    if (slot < 4) sc *= 0.08838834764831845f;
    a0 *= sc;
    a1 *= sc;
  }
  *(unsigned*)(Q + (size_t)row * 1536 + ch) = pack2(a0, a1);
}

__device__ __forceinline__ void gdn_bg(const P& p, int l, int row, int dir, int h, float& beta, float& g) {
  const float* BA = (const float*)(lptr(p.ws) + OFF_BA) + (size_t)row * 16;
  beta = sigm(BA[dir * 4 + h]);
  float a = BA[8 + dir * 4 + h] + lptr(p.in[12])[(l * 2 + dir) * 4 + h];
  float sp = a > 20.f ? a : log1pf(expf(a));
  g = -expf(lptr(p.in[11])[(l * 2 + dir) * 4 + h]) * sp;
}

__device__ void tphase_b(const P& p, int l, int item, char* smem) {
  const int t = TID(), lane = t & 63, w = t >> 6;
  const int c = item % 68;
  const int rest = item / 68;
  const int dir = rest & 1, h = (rest >> 1) & 3, b = rest >> 3;
  u16* ks = (u16*)smem;
  float* Am = (float*)(ks + 64 * 136);
  float* cumL = Am + 64 * 68;
  float* betL = cumL + 64;
  const u16* Q = (const u16*)(lptr(p.ws) + OFF_R + R_QKV);
  u16* PB = (u16*)(lptr(p.ws) + OFF_R + R_PB);
  __syncthreads();
  {
    int tau = t >> 3, d0 = (t & 7) * 16;
    int row = chain_row(b, dir, c, tau);
    const u16* src = Q + (size_t)row * 1536 + 512 + h * 128 + d0;
    *(uint4*)(ks + tau * 136 + d0) = *(const uint4*)src;
    *(uint4*)(ks + tau * 136 + d0 + 8) = *(const uint4*)(src + 8);
  }
  if (t < 64) {
    int row = chain_row(b, dir, c, t);
    float beta, g;
    gdn_bg(p, l, row, dir, h, beta, g);
    float cs = g;
#pragma unroll
    for (int o = 1; o < 64; o <<= 1) {
      float n = __shfl_up(cs, o, 64);
      if (lane >= o) cs += n;
    }
    cumL[t] = cs;
    betL[t] = beta;
  }
  __syncthreads();
  {
    const int fr = lane & 15, fq = lane >> 4;
    int tt = w >> 1;
#pragma unroll
    for (int u = 0; u < 2; ++u) {
      int st = (w & 1) * 2 + u;
      f32x4 a = f32x4{0.f, 0.f, 0.f, 0.f};
      if (st <= tt) {
#pragma unroll
        for (int k2 = 0; k2 < 4; ++k2)
          a = MFMA(ldfrag(ks, st * 16 + fr, 136, k2 * 32 + fq * 8), ldfrag(ks, tt * 16 + fr, 136, k2 * 32 + fq * 8), a);
      }
      int tau = tt * 16 + fr;
      float ct = cumL[tau], bt = betL[tau];
#pragma unroll
      for (int r = 0; r < 4; ++r) {
        int sg = st * 16 + fq * 4 + r;
        float val = (sg < tau) ? bt * a[r] * __expf(ct - cumL[sg]) : 0.f;
        Am[sg * 68 + tau] = val;
      }
    }
  }
  __syncthreads();
  if (t < 64) {
    float* Tm = betL + 64;
#pragma unroll 1
    for (int I = 0; I < 4; ++I) {
      float r[16];
#pragma unroll
      for (int i = 0; i < 16; ++i) r[i] = (16 * I + i == t) ? 1.f : 0.f;
#pragma unroll 1
      for (int sg = 0; sg < 16 * I; ++sg) {
        float xs = Tm[sg * 65 + t];
        const float4* ap = (const float4*)(Am + sg * 68 + 16 * I);
        float4 a0 = ap[0], a1 = ap[1], a2 = ap[2], a3 = ap[3];
        r[0] -= a0.x * xs; r[1] -= a0.y * xs; r[2] -= a0.z * xs; r[3] -= a0.w * xs;
        r[4] -= a1.x * xs; r[5] -= a1.y * xs; r[6] -= a1.z * xs; r[7] -= a1.w * xs;
        r[8] -= a2.x * xs; r[9] -= a2.y * xs; r[10] -= a2.z * xs; r[11] -= a2.w * xs;
        r[12] -= a3.x * xs; r[13] -= a3.y * xs; r[14] -= a3.z * xs; r[15] -= a3.w * xs;
      }
#pragma unroll
      for (int ip = 0; ip < 16; ++ip) {
        float x = r[ip];
        Tm[(16 * I + ip) * 65 + t] = x;
        const float4* ap = (const float4*)(Am + (16 * I + ip) * 68 + 16 * I);
        float4 a0 = ap[0], a1 = ap[1], a2 = ap[2], a3 = ap[3];
        const float aa[16] = {a0.x, a0.y, a0.z, a0.w, a1.x, a1.y, a1.z, a1.w, a2.x, a2.y, a2.z, a2.w, a3.x, a3.y, a3.z, a3.w};
#pragma unroll
        for (int i = 0; i < 16; ++i)
          if (i > ip) r[i] -= aa[i] * x;
      }
    }
    float bt = betL[t];
#pragma unroll 4
    for (int tau = 0; tau < 64; ++tau) {
      int row = chain_row(b, dir, c, tau);
      PB[(size_t)row * 2176 + h * 128 + dir * 64 + t] = f2bf(Tm[tau * 65 + t] * bt);
    }
  }
}

__device__ void chain_b(const P& p, int l, int item, char* smem) {
  const int t = TID(), lane = t & 63, w = t >> 6;
  const int vs = item & 3, dir = (item >> 2) & 1, h = (item >> 3) & 3, b = item >> 5;
  u16* qs = (u16*)smem;
  u16* ks = qs + 64 * 136;
  u16* wl = ks + 64 * 136;
  u16* kT = wl + 64 * 136;
  u16* Tu = kT + 128 * 72;
  u16* Tw = Tu + 64 * 72;
  u16* at = Tw + 64 * 72;
  u16* vT = at + 64 * 72;
  u16* vnT = vT + 32 * 72;
  u16* vnsT = vnT + 32 * 72;
  u16* sT = vnsT + 32 * 72;
  float* cumL = (float*)(sT + 32 * 136);
  float* ecum = cumL + 64;
  float* elc = ecum + 64;
  float* misc = elc + 64;
  const u16* Q = (const u16*)(lptr(p.ws) + OFF_R + R_QKV);
  u16* PB = (u16*)(lptr(p.ws) + OFF_R + R_PB);
  const int fr = lane & 15, fq = lane >> 4;
  f32x4 S[2];
  S[0] = f32x4{0.f, 0.f, 0.f, 0.f};
  S[1] = S[0];
  for (int c = 0; c < 68; ++c) {
    __syncthreads();
    {
      int tau = t >> 3, d0 = (t & 7) * 16;
      int row = chain_row(b, dir, c, tau);
      const u16* sq = Q + (size_t)row * 1536 + h * 128 + d0;
      uint4 q0 = *(const uint4*)sq, q1 = *(const uint4*)(sq + 8);
      uint4 k0 = *(const uint4*)(sq + 512), k1 = *(const uint4*)(sq + 520);
      *(uint4*)(qs + tau * 136 + d0) = q0;
      *(uint4*)(qs + tau * 136 + d0 + 8) = q1;
      *(uint4*)(ks + tau * 136 + d0) = k0;
      *(uint4*)(ks + tau * 136 + d0 + 8) = k1;
      const unsigned kk[8] = {k0.x, k0.y, k0.z, k0.w, k1.x, k1.y, k1.z, k1.w};
#pragma unroll
      for (int i = 0; i < 8; ++i) {
        kT[(d0 + 2 * i) * 72 + tau] = (u16)(kk[i] & 0xffff);
        kT[(d0 + 2 * i + 1) * 72 + tau] = (u16)(kk[i] >> 16);
      }
      int v4 = (t & 7) * 4;
      uint2 raw = *(const uint2*)(Q + (size_t)row * 1536 + 1024 + h * 128 + vs * 32 + v4);
      vT[(v4 + 0) * 72 + tau] = (u16)(raw.x & 0xffff);
      vT[(v4 + 1) * 72 + tau] = (u16)(raw.x >> 16);
      vT[(v4 + 2) * 72 + tau] = (u16)(raw.y & 0xffff);
      vT[(v4 + 3) * 72 + tau] = (u16)(raw.y >> 16);
    }
    if (t < 64) {
      int row = chain_row(b, dir, c, t);
      float beta, g;
      gdn_bg(p, l, row, dir, h, beta, g);
      float cs = g;
#pragma unroll
      for (int o = 1; o < 64; o <<= 1) {
        float n = __shfl_up(cs, o, 64);
        if (lane >= o) cs += n;
      }
      float last = __shfl(cs, 63, 64);
      cumL[t] = cs;
      ecum[t] = __expf(cs);
      elc[t] = __expf(last - cs);
      if (t == 0) misc[0] = __expf(last);
    }
#pragma unroll
    for (int vt = 0; vt < 2; ++vt) *(uint2*)(sT + (vt * 16 + fr) * 136 + w * 16 + fq * 4) = pack4(S[vt]);
    __syncthreads();
    {
      int tau = t >> 3, s0 = (t & 7) * 8;
      int row = chain_row(b, dir, c, tau);
      uint4 tv = *(const uint4*)(PB + (size_t)row * 2176 + h * 128 + dir * 64 + s0);
      *(uint4*)(Tu + tau * 72 + s0) = tv;
      const unsigned tw[4] = {tv.x, tv.y, tv.z, tv.w};
      uint4 o;
      unsigned* op = &o.x;
#pragma unroll
      for (int i = 0; i < 4; ++i) {
        float a0 = bf2f((u16)(tw[i] & 0xffff)) * ecum[s0 + 2 * i];
        float a1 = bf2f((u16)(tw[i] >> 16)) * ecum[s0 + 2 * i + 1];
        op[i] = pack2(a0, a1);
      }
      *(uint4*)(Tw + tau * 72 + s0) = o;
    }
    __syncthreads();
    const int vt = w & 1, tt = w >> 1;
    f32x4 au = f32x4{0.f, 0.f, 0.f, 0.f};
    {
#pragma unroll
      for (int u = 0; u < 2; ++u) {
        int st = (w & 1) * 2 + u;
        f32x4 a = f32x4{0.f, 0.f, 0.f, 0.f};
        if (st <= tt) {
#pragma unroll
          for (int k2 = 0; k2 < 4; ++k2)
            a = MFMA(ldfrag(ks, st * 16 + fr, 136, k2 * 32 + fq * 8), ldfrag(qs, tt * 16 + fr, 136, k2 * 32 + fq * 8), a);
          int tau = tt * 16 + fr;
          float ct = cumL[tau];
#pragma unroll
          for (int r = 0; r < 4; ++r) {
            int sg = st * 16 + fq * 4 + r;
            a[r] = (sg <= tau) ? a[r] * __expf(ct - cumL[sg]) : 0.f;
          }
        }
        *(uint2*)(at + (tt * 16 + fr) * 72 + st * 16 + fq * 4) = pack4(a);
      }
#pragma unroll
      for (int k2 = 0; k2 < 2; ++k2)
        au = MFMA(ldfrag(vT, vt * 16 + fr, 72, k2 * 32 + fq * 8), ldfrag(Tu, tt * 16 + fr, 72, k2 * 32 + fq * 8), au);
#pragma unroll
      for (int t2 = 0; t2 < 4; ++t2) {
        f32x4 a = f32x4{0.f, 0.f, 0.f, 0.f};
#pragma unroll
        for (int k2 = 0; k2 < 2; ++k2)
          a = MFMA(ldfrag(kT, w * 16 + fr, 72, k2 * 32 + fq * 8), ldfrag(Tw, t2 * 16 + fr, 72, k2 * 32 + fq * 8), a);
        *(uint2*)(wl + (t2 * 16 + fr) * 136 + w * 16 + fq * 4) = pack4(a);
      }
    }
    __syncthreads();
    {
      f32x4 a = f32x4{0.f, 0.f, 0.f, 0.f};
#pragma unroll
      for (int k2 = 0; k2 < 4; ++k2)
        a = MFMA(ldfrag(sT, vt * 16 + fr, 136, k2 * 32 + fq * 8), ldfrag(wl, tt * 16 + fr, 136, k2 * 32 + fq * 8), a);
      int tau = tt * 16 + fr;
      float el = elc[tau];
#pragma unroll
      for (int r = 0; r < 4; ++r) {
        float vn = au[r] - a[r];
        int vv = vt * 16 + fq * 4 + r;
        vnT[vv * 72 + tau] = f2bf(vn);
        vnsT[vv * 72 + tau] = f2bf(vn * el);
      }
    }
    __syncthreads();
    {
      f32x4 a1 = f32x4{0.f, 0.f, 0.f, 0.f}, a2 = f32x4{0.f, 0.f, 0.f, 0.f};
#pragma unroll
      for (int k2 = 0; k2 < 4; ++k2)
        a1 = MFMA(ldfrag(sT, vt * 16 + fr, 136, k2 * 32 + fq * 8), ldfrag(qs, tt * 16 + fr, 136, k2 * 32 + fq * 8), a1);
#pragma unroll
      for (int k2 = 0; k2 < 2; ++k2)
        a2 = MFMA(ldfrag(vnT, vt * 16 + fr, 72, k2 * 32 + fq * 8), ldfrag(at, tt * 16 + fr, 72, k2 * 32 + fq * 8), a2);
      int tau = tt * 16 + fr;
      float ec = ecum[tau];
      f32x4 o;
#pragma unroll
      for (int r = 0; r < 4; ++r) o[r] = ec * a1[r] + a2[r];
      int row = chain_row(b, dir, c, tau);
      *(uint2*)(PB + (size_t)row * 2176 + 512 + dir * 512 + h * 128 + vs * 32 + vt * 16 + fq * 4) = pack4(o);
      float elast = misc[0];
#pragma unroll
      for (int v2 = 0; v2 < 2; ++v2) {
        f32x4 ds = f32x4{0.f, 0.f, 0.f, 0.f};
#pragma unroll
        for (int k2 = 0; k2 < 2; ++k2)
          ds = MFMA(ldfrag(kT, w * 16 + fr, 72, k2 * 32 + fq * 8), ldfrag(vnsT, v2 * 16 + fr, 72, k2 * 32 + fq * 8), ds);
#pragma unroll
        for (int r = 0; r < 4; ++r) S[v2][r] = elast * S[v2][r] + ds[r];
      }
    }
  }
}

__device__ void s5_tables(const P& p, int l, int item, char* smem) {
  const int t = TID();
  char* R = lptr(p.ws) + OFF_R;
  if (item < 2048) {
    const int g = item >> 6, tau = item & 63;
    float2* pw = (float2*)smem;
    float2* Cc = pw + 128;
    __syncthreads();
    if (t < 128) {
      int dirx = t >> 6, s = t & 63;
      S5c c = s5_load(p, l, dirx, g, s);
      double pr, pi;
      s5_pow(c, dirx == 0 ? tau + 1 : 64 - tau, pr, pi);
      pw[t] = float2{(float)pr, (float)pi};
    }
    for (int e = t; e < 1024; e += NT) {
      int co = e >> 6, s2 = e & 63;
      Cc[e] = float2{lptr(p.in[19])[((size_t)(l * 32 + g) * 16 + co) * 64 + s2], lptr(p.in[20])[((size_t)(l * 32 + g) * 16 + co) * 64 + s2]};
    }
    __syncthreads();
    const float* KT = (const float*)(lptr(p.ws) + OFF_KT);
    u16* BP = (u16*)(R + R_BP);
    for (int e = t; e < 16 * 1280; e += NT) {
      int co = e / 1280, k = e % 1280;
      float val;
      if (k < 1024) {
        int sg = k >> 4, ci = k & 15;
        val = 0.f;
        if (sg <= tau) val += KT[((size_t)((0 * 32 + g) * 64 + (tau - sg))) * 256 + co * 16 + ci];
        if (sg >= tau) val += KT[((size_t)((1 * 32 + g) * 64 + (sg - tau))) * 256 + co * 16 + ci];
        if (sg == tau && co == ci) val += lptr(p.in[21])[l * 512 + g * 16 + co];
      } else {
        int kk = k - 1024;
        int dirx = kk >> 7, si = kk & 127, s = si & 63, isim = si >> 6;
        float2 pp = pw[dirx * 64 + s], cc = Cc[co * 64 + s];
        float re = cc.x * pp.x - cc.y * pp.y, im = cc.x * pp.y + cc.y * pp.x;
        val = isim ? -im : re;
      }
      BP[((size_t)(g * 1024 + tau * 16 + co)) * 1280 + k] = f2bf(val);
    }
  } else {
    item -= 2048;
    const int sg = item & 63, g = (item >> 6) & 31, dir = item >> 11;
    double2* pc = (double2*)smem;
    __syncthreads();
    if (t < 64) {
      S5c c = s5_load(p, l, dir, g, t);
      double pr, pi, cr, ci;
      s5_pow(c, dir == 0 ? 63 - sg : sg, pr, pi);
      s5_coef(c, cr, ci);
      pc[t] = double2{pr * cr - pi * ci, pr * ci + pi * cr};
    }
    __syncthreads();
    u16* M1 = (u16*)(R + R_M1);
    for (int e = t; e < 2048; e += NT) {
      int n = e >> 4, ci2 = e & 15;
      int s = n & 63, isim = n >> 6;
      double br = lptr(p.in[17])[((size_t)(l * 32 + g) * 64 + s) * 16 + ci2];
      double bi = lptr(p.in[18])[((size_t)(l * 32 + g) * 64 + s) * 16 + ci2];
      double2 q = pc[s];
      double v = isim ? (q.x * bi + q.y * br) : (q.x * br - q.y * bi);
      M1[((size_t)((dir * 32 + g) * 128 + n)) * 1024 + sg * 16 + ci2] = f2bf((float)v);
    }
  }
}

__device__ void s5_state(const P& p, int tile, char* smem) {
  char* R = lptr(p.ws) + OFF_R;
  const int dg = tile / 3, tm = tile % 3;
  const int g = dg & 31;
  f32x4 acc[4][4];
  zero_acc(acc);
  gemm_loop((const u16*)(R + R_UG) + ((size_t)(g * 768 + tm * 256)) * 1280, 1280,
            (const u16*)(R + R_M1) + (size_t)dg * 128 * 1024, 1024, 1024, smem, acc);
  float* DS = (float*)(R + R_DS);
  EPI_LOOP({
    int chunk = tm * 256 + ml;
    if (chunk < 544) *(float4*)(DS + ((size_t)(dg * 768 + chunk)) * 128 + nl) = float4{v[0], v[1], v[2], v[3]};
  })
}

__device__ void s5_scan(const P& p, int l, int item) {
  const int id = item * NT + TID();
  const int s = id & 63, g = (id >> 6) & 31, dir = (id >> 11) & 1, b = id >> 12;
  char* R = lptr(p.ws) + OFF_R;
  S5c c = s5_load(p, l, dir, g, s);
  double ar, ai;
  s5_pow(c, 64, ar, ai);
  const float a_r = (float)ar, a_i = (float)ai;
  const float* DS = (const float*)(R + R_DS);
  u16* UG = (u16*)(R + R_UG);
  float xr = 0.f, xi = 0.f;
  for (int step = 0; step < 68; ++step) {
    int c68 = dir == 0 ? step : (step < 4 ? 3 - step : 71 - step);
    int chunk = b * 68 + c68;
    u16* up = UG + ((size_t)(g * 768 + chunk)) * 1280 + 1024 + dir * 128;
    up[s] = f2bf(xr);
    up[64 + s] = f2bf(xi);
    const float* dp = DS + ((size_t)((dir * 32 + g) * 768 + chunk)) * 128;
    float dr = dp[s], di = dp[64 + s];
    float nr = a_r * xr - a_i * xi + dr;
    float ni = a_r * xi + a_i * xr + di;
    xr = nr;
    xi = ni;
  }
}

__device__ void s5_out(const P& p, int tile, char* smem) {
  char* R = lptr(p.ws) + OFF_R;
  const int g = tile / 24, rem = tile % 24, tm = rem >> 3, tn = rem & 7;
  f32x4 acc[4][4];
  zero_acc(acc);
  gemm_loop((const u16*)(R + R_UG) + ((size_t)(g * 768 + tm * 256)) * 1280, 1280,
            (const u16*)(R + R_BP) + ((size_t)(g * 1024 + tn * 128)) * 1280, 1280, 1280, smem, acc);
  u16* ZC = (u16*)(R + R_ZC);
  EPI_LOOP({
    int chunk = tm * 256 + ml;
    if (chunk < 544) {
      int n = tn * 128 + nl;
      int tau = n >> 4, co = n & 15;
      int b = chunk / 68, c68 = chunk % 68;
      int row = c68 < 4 ? MLAT + b * 256 + c68 * 64 + tau : b * 4096 + tau * 64 + (c68 - 4);
      f32x4 z;
      _Pragma("unroll") for (int r = 0; r < 4; ++r) z[r] = geluf(v[r]);
      *(uint2*)(ZC + (size_t)row * 512 + g * 16 + co) = pack4(z);
    }
  })
}

__device__ void glu_gemm(const P& p, int tile, char* smem) {
  char* R = lptr(p.ws) + OFF_R;
  const int tm = tile >> 2, tn = tile & 3;
  const int m0 = tm * 256, n0 = tn * 128;
  const u16* ZC = (const u16*)(R + R_ZC);
  f32x4 acc[4][4];
  zero_acc(acc);
  gemm_loop(ZC + (size_t)m0 * 512, 512, (const u16*)(lptr(p.ws) + OFF_WT) + W_GLU + (size_t)n0 * 512, 512, 512, smem, acc);
  u16* GL = (u16*)(lptr(p.ws) + OFF_GL);
  EPI_LOOP({
    uint2 zr = *(const uint2*)(ZC + (size_t)(m0 + ml) * 512 + n0 + nl);
    f32x4 o;
    o[0] = bf2f((u16)(zr.x & 0xffff)) * sigm(v[0]);
    o[1] = bf2f((u16)(zr.x >> 16)) * sigm(v[1]);
    o[2] = bf2f((u16)(zr.y & 0xffff)) * sigm(v[2]);
    o[3] = bf2f((u16)(zr.y >> 16)) * sigm(v[3]);
    *(uint2*)(GL + (size_t)(m0 + ml) * 512 + n0 + nl) = pack4(o);
  })
}

__device__ void mix_gemm(const P& p, int tile, char* smem) {
  const int tm = tile >> 3, tn = tile & 7;
  const int m0 = tm * 256, n0 = tn * 128;
  const u16* WT = (const u16*)(lptr(p.ws) + OFF_WT);
  const u16* PG = (const u16*)(lptr(p.ws) + OFF_R + R_PG);
  uint2 tot[4][4];
  u16* MIX = (u16*)(lptr(p.ws) + OFF_H);
#pragma unroll 1
  for (int br = 0; br < 3; ++br) {
    const u16* A = (const u16*)(lptr(p.ws) + (br == 0 ? OFF_NA : br == 1 ? OFF_NB : OFF_GL)) + (size_t)m0 * 512;
    const u16* W = WT + W_BA + (size_t)br * 524288 + (size_t)n0 * 512;
    f32x4 acc[4][4];
    zero_acc(acc);
    gemm_loop(A, 512, W, 512, 512, smem, acc);
    EPI_LOOP({
      uint2 gr = *(const uint2*)(PG + (size_t)(m0 + ml) * 3072 + br * 1024 + n0 + nl);
      f32x4 o;
      o[0] = bf2f((u16)(gr.x & 0xffff)) * v[0];
      o[1] = bf2f((u16)(gr.x >> 16)) * v[1];
      o[2] = bf2f((u16)(gr.y & 0xffff)) * v[2];
      o[3] = bf2f((u16)(gr.y >> 16)) * v[3];
      if (br > 0) {
        uint2 pv = tot[_i][_j];
        o[0] += bf2f((u16)(pv.x & 0xffff));
        o[1] += bf2f((u16)(pv.x >> 16));
        o[2] += bf2f((u16)(pv.y & 0xffff));
        o[3] += bf2f((u16)(pv.y >> 16));
      }
      uint2 pk = pack4(o);
      tot[_i][_j] = pk;
      if (br == 2) *(uint2*)(MIX + (size_t)(m0 + ml) * 1024 + n0 + nl) = pk;
    })
  }
}

__device__ void res_gemm(const P& p, int l, int which, int tile, char* smem) {
  const int tm = tile >> 3, tn = tile & 7;
  const int m0 = tm * 256, n0 = tn * 128;
  const u16* WT = (const u16*)(lptr(p.ws) + OFF_WT);
  f32x4 acc[4][4];
  zero_acc(acc);
  if (which == 0)
    gemm_loop((const u16*)(lptr(p.ws) + OFF_H) + (size_t)m0 * 1024, 1024, WT + W_O + (size_t)n0 * 1024, 1024, 1024, smem, acc);
  else
    gemm_loop((const u16*)(lptr(p.ws) + OFF_R + R_HID) + (size_t)m0 * 4096, 4096, WT + W_FF2 + (size_t)n0 * 4096, 4096, 4096, smem, acc);
  const float* modsb = (const float*)(lptr(p.ws) + OFF_MODS) + (size_t)l * 9 * 6144 + (which == 0 ? 2 : 5) * 1024;
  EPI_LOOP({
    int m = m0 + ml, n = n0 + nl;
    const float* src;
    float* dst;
    if (m < MLAT) {
      src = ((which == 0 && l == 0) ? lptr(p.in[0]) : lptr(p.out)) + (size_t)m * 1024 + n;
      dst = lptr(p.out) + (size_t)m * 1024 + n;
    } else {
      dst = (float*)(lptr(p.ws) + OFF_XC) + (size_t)(m - MLAT) * 1024 + n;
      src = dst;
    }
    float4 x = *(const float4*)src;
    float4 gt = *(const float4*)(modsb + (size_t)mod_idx(m) * 6144 + n);
    x.x += gt.x * v[0]; x.y += gt.y * v[1]; x.z += gt.z * v[2]; x.w += gt.w * v[3];
    *(float4*)dst = x;
  })
}

__device__ void final_norm(const P& p, int item) {
  const int t = TID(), lane = t & 63, w = t >> 6;
  const int r = item * 8 + w;
  float* xr = lptr(p.out) + (size_t)r * 1024;
  float4 v[4];
  float ss = 0.f;
#pragma unroll
  for (int i = 0; i < 4; ++i) {
    v[i] = *(const float4*)(xr + i * 256 + lane * 4);
    ss += v[i].x * v[i].x + v[i].y * v[i].y + v[i].z * v[i].z + v[i].w * v[i].w;
  }
  ss = wsum(ss);
  float rstd = rsqrtf(ss * (1.f / 1024.f) + 1e-6f);
#pragma unroll
  for (int i = 0; i < 4; ++i) {
    int c = i * 256 + lane * 4;
    float4 wv = *(const float4*)(lptr(p.in[30]) + c);
    float4 o{v[i].x * rstd * wv.x, v[i].y * rstd * wv.y, v[i].z * rstd * wv.z, v[i].w * rstd * wv.w};
    *(float4*)(xr + c) = o;
  }
}

#define NSUB 19
#define NPHASE (1 + 2 * NSUB + 1)

__device__ void run_phase(const P& p, int ph, char* smem) {
  const int bid = blockIdx.x, nb = gridDim.x;
  if (ph == 0) { for (int i = bid; i < 449; i += nb) ph_init(p, i, smem); return; }
  if (ph == NPHASE - 1) { for (int i = bid; i < 4096; i += nb) final_norm(p, i); return; }
  const int l = (ph - 1) / NSUB, sub = (ph - 1) % NSUB;
  switch (sub) {
    case 0: for (int i = bid; i < 4832 + 4352 + 4096; i += nb) ph_start(p, l, i, smem); break;
    case 1: for (int i = bid; i < 136 * 20; i += nb) gemm_simple(p, 0, i, smem); break;
    case 2: for (int i = bid; i < 256; i += nb) chain_a(p, l, i, smem); break;
    case 3: for (int i = bid; i < 17408; i += nb) normgate(p, l, i, 0); break;
    case 4: for (int i = bid; i < 136 * 17; i += nb) gemm_simple(p, 1, i, smem); break;
    case 5: for (int i = bid; i < 52224; i += nb) conv_b(p, l, i); break;
    case 6: for (int i = bid; i < 4352; i += nb) tphase_b(p, l, i, smem); break;
    case 7: for (int i = bid; i < 256; i += nb) chain_b(p, l, i, smem); break;
    case 8: for (int i = bid; i < 17408; i += nb) normgate(p, l, i, 1); break;
    case 9:
      for (int i = bid; i < 136 * 4 + 6144; i += nb) {
        if (i < 544) gemm_simple(p, 2, i, smem); else s5_tables(p, l, i - 544, smem);
      }
      break;
    case 10: for (int i = bid; i < 192; i += nb) s5_state(p, i, smem); break;
    case 11: for (int i = bid; i < 64; i += nb) s5_scan(p, l, i); break;
    case 12: for (int i = bid; i < 768; i += nb) s5_out(p, i, smem); break;
    case 13:
      for (int i = bid; i < 136 * 24 + 544; i += nb) {
        if (i < 544) glu_gemm(p, i, smem); else gemm_simple(p, 3, i - 544, smem);
      }
      break;
    case 14: for (int i = bid; i < 136 * 8; i += nb) mix_gemm(p, i, smem); break;
    case 15: for (int i = bid; i < 136 * 8; i += nb) res_gemm(p, l, 0, i, smem); break;
    case 16: for (int i = bid; i < 4352; i += nb) norm_rows(p, l, i, 1); break;
    case 17: for (int i = bid; i < 136 * 32; i += nb) gemm_simple(p, 4, i, smem); break;
    case 18: for (int i = bid; i < 136 * 8; i += nb) res_gemm(p, l, 1, i, smem); break;
  }
}

__global__ void __launch_bounds__(NT) mega(P p, int ph_lo, int ph_hi) {
  extern __shared__ __attribute__((aligned(16))) char smem[];
  cg::grid_group grid = cg::this_grid();
  for (int ph = ph_lo; ph < ph_hi; ++ph) {
    run_phase(p, ph, smem);
    if (ph + 1 < ph_hi) grid.sync();
  }
}

extern "C" void kernel_launch(void* const* d_in, const int* in_sizes, int n_in, void* d_out, int out_size, void* d_ws,
                              size_t ws_size, hipStream_t stream) {
  static int grid_blocks = 0;
  if (!grid_blocks) {
    hipFuncSetAttribute((const void*)mega, hipFuncAttributeMaxDynamicSharedMemorySize, LDS_BYTES);
    int dev = 0, cus = 0, per_cu = 0;
    hipGetDevice(&dev);
    hipDeviceGetAttribute(&cus, hipDeviceAttributeMultiprocessorCount, dev);
    hipOccupancyMaxActiveBlocksPerMultiprocessor(&per_cu, mega, NT, LDS_BYTES);
    if (per_cu < 1) per_cu = 1;
    grid_blocks = cus * per_cu;
  }
  P p{};
  for (int i = 0; i < 31; ++i) p.in[i] = (const float*)d_in[i];
  p.out = (float*)d_out;
  p.ws = (char*)d_ws;
#if COOP
  int lo = 0, hi = NPHASE;
  void* args[] = {&p, &lo, &hi};
  hipError_t e = hipLaunchCooperativeKernel((void*)mega, dim3(grid_blocks), dim3(NT), args, LDS_BYTES, stream);
  if (e != hipSuccess) fprintf(stderr, "cooperative launch failed: %s (grid %d)\n", hipGetErrorString(e), grid_blocks);
#else
  for (int ph = 0; ph < NPHASE; ++ph) mega<<<grid_blocks, NT, LDS_BYTES, stream>>>(p, ph, ph + 1);
#endif
}
```

```cpp
#include <hip/hip_runtime.h>
#include <hip/hip_cooperative_groups.h>
#include <cstdio>
namespace cg = cooperative_groups;

typedef unsigned short u16;
typedef __attribute__((ext_vector_type(8))) short bf16x8;
typedef __attribute__((ext_vector_type(4))) float f32x4;
typedef __attribute__((ext_vector_type(4))) unsigned int u32x4;

#ifndef COOP
#define COOP 1
#endif

#define NT 512
#define MLAT 32768
#define MALL 34816
#define LDS_BYTES (131072 + 64)

constexpr size_t SZ_WT   = 19922944ull * 2;
constexpr size_t OFF_WT  = 0;
constexpr size_t OFF_H   = OFF_WT + SZ_WT;
constexpr size_t SZ_H    = 34816ull * 1024 * 2;
constexpr size_t SZ_N    = 34816ull * 512 * 2;
constexpr size_t OFF_NA  = OFF_H + SZ_H;
constexpr size_t OFF_NB  = OFF_NA + SZ_N;
constexpr size_t OFF_GL  = OFF_NB + SZ_N;
constexpr size_t OFF_XC  = OFF_GL + SZ_N;
constexpr size_t OFF_MODS = OFF_XC + 2048ull * 1024 * 4;
constexpr size_t OFF_LB  = OFF_MODS + 442368;
constexpr size_t OFF_KT  = OFF_LB + 8192;
constexpr size_t OFF_BA  = OFF_KT + 4194304;
constexpr size_t OFF_R   = OFF_BA + 34816ull * 16 * 4;
constexpr size_t OFF_BAR = OFF_R + 34816ull * 4096 * 2;
constexpr size_t R_PA = 0;
constexpr size_t R_OF = 34816ull * 2560 * 2;
constexpr size_t R_OB = R_OF + SZ_N;
constexpr size_t R_PB = 0;
constexpr size_t R_QKV = 34816ull * 2304 * 2;
constexpr size_t R_UG = 0;
constexpr size_t R_BP = 32ull * 768 * 1280 * 2;
constexpr size_t R_M1 = R_BP + 32ull * 1024 * 1280 * 2;
constexpr size_t R_DS = R_M1 + 64ull * 128 * 1024 * 2;
constexpr size_t R_ZC = 240000000ull;
constexpr size_t R_PG = 0;
constexpr size_t R_HID = 0;
constexpr size_t W_IN = 0, W_FF1 = 8650752, W_FF2 = 12845056, W_O = 17039360, W_BA = 18087936,
                 W_BB = 18612224, W_BC = 19136512, W_GLU = 19660800;

struct P {
  const float* in[31];
  float* out;
  char* ws;
};

__device__ __forceinline__ int TID() { int t = threadIdx.x; asm volatile("" : "+v"(t)); return t; }
template <class T> __device__ __forceinline__ T* lptr(T* q) {
  unsigned long long v = (unsigned long long)q;
  unsigned lo = __builtin_amdgcn_readfirstlane((unsigned)v), hi = __builtin_amdgcn_readfirstlane((unsigned)(v >> 32));
  asm volatile("" : "+s"(lo), "+s"(hi));
  typedef __attribute__((address_space(1))) T GT;
  GT* g = (GT*)(((unsigned long long)hi << 32) | lo);
  return (T*)g;
}

__device__ __forceinline__ u16 f2bf(float f) {
  __bf16 b = (__bf16)f;
  return __builtin_bit_cast(u16, b);
}
__device__ __forceinline__ float bf2f(u16 h) { return __uint_as_float(((unsigned)h) << 16); }
typedef float f2v_t __attribute__((ext_vector_type(2)));
typedef __bf16 bf2v_t __attribute__((ext_vector_type(2)));
__device__ __forceinline__ unsigned pack2(float a, float b) {
  f2v_t v = {a, b};
  bf2v_t r = __builtin_convertvector(v, bf2v_t);
  return __builtin_bit_cast(unsigned, r);
}
__device__ __forceinline__ uint2 pack4(f32x4 v) { uint2 r; r.x = pack2(v[0], v[1]); r.y = pack2(v[2], v[3]); return r; }
__device__ __forceinline__ float wsum(float v) {
#pragma unroll
  for (int o = 32; o > 0; o >>= 1) v += __shfl_xor(v, o, 64);
  return v;
}
__device__ __forceinline__ float sigm(float x) { return __builtin_amdgcn_rcpf(1.f + __expf(-x)); }
__device__ __forceinline__ float siluf(float x) { return x * __builtin_amdgcn_rcpf(1.f + __expf(-x)); }
__device__ __forceinline__ float geluf(float x) {
  float u = 1.5957691216057308f * (x + 0.044715f * x * x * x);
  return x * __builtin_amdgcn_rcpf(1.f + __expf(-u));
}
__device__ __forceinline__ bf16x8 ldfrag(const u16* base, int row, int stride, int koff) {
  return *(const bf16x8*)(base + row * stride + koff);
}
#define LDS_SYNC() do { asm volatile("s_waitcnt lgkmcnt(0)" ::: "memory"); __builtin_amdgcn_s_barrier(); asm volatile("" ::: "memory"); } while (0)
#define MFMA(a, b, c) __builtin_amdgcn_mfma_f32_16x16x32_bf16(a, b, c, 0, 0, 0)

__device__ __forceinline__ int chain_row(int b, int dir, int c, int tau) {
  if (dir == 0) {
    if (c < 4) return MLAT + b * 256 + c * 64 + tau;
    return b * 4096 + (c - 4) * 64 + tau;
  } else {
    if (c < 4) return MLAT + b * 256 + (3 - c) * 64 + 63 - tau;
    return b * 4096 + (67 - c) * 64 + 63 - tau;
  }
}

namespace pg8 {
#define PG8_LAS __attribute__((address_space(3)))
typedef unsigned short bf16_t;
typedef short bf16x8 __attribute__((ext_vector_type(8)));
typedef float f32x4 __attribute__((ext_vector_type(4)));
typedef unsigned u32x4 __attribute__((ext_vector_type(4)));
constexpr int BM = 256, BK = 64, HALF = 128, HTB = HALF * BK * 2  , STAGE_BYTES = 8 * HTB, NXCD = 8, WGM = 8;

__host__ __device__ __forceinline__ int lds_byte(int r, int c) { const int st = (r >> 4) * 2 + (c >> 5), rr = r & 15, cc = c & 31, ob = rr * 64 + cc * 2; return st * 1024 + (ob ^ (((ob >> 9) & 1) << 5)); }
__host__ __device__ __forceinline__ void stage_rc(int b, int& R, int& C) { const int st = b / 1024, sb = b % 1024, swz = sb ^ (((sb >> 9) & 1) << 5); R = (st >> 1) * 16 + swz / 64; C = (st & 1) * 32 + (swz % 64) / 2; }
__host__ __device__ __forceinline__ int perm32(int rho) { const int n = rho >> 4, i = rho & 15; return 8 * (i >> 2) + 4 * n + (i & 3); }

struct Unit { int pm, pn; };
struct Gemm { const bf16_t* A; const bf16_t* Bt; int M, N, K; };

template <class Epi, class Sched, bool STAMP = false>
__device__ __forceinline__ void gemm_phase(PG8_LAS unsigned char* lds, const Gemm g, const Sched& S, const Epi& E, unsigned long long* stamps) {
    const int tid = TID(), wid = __builtin_amdgcn_readfirstlane(tid >> 6), lane = tid & 63, wr = wid >> 2, wc = wid & 3, fr = lane & 15, fq = lane >> 4;
    const int K = g.K, nt = K / BK;
    int ts_lo = 0, ts_hi = 0, nts = 0; const unsigned long long rt_entry = STAMP ? (unsigned long long)wall_clock64() : 0ull;
#define PG8_STAMP() do { if (STAMP && wid == 0 && nts < 64) { const unsigned long long _c = (unsigned long long)clock64(); \
        ts_lo = (lane == nts) ? (int)(unsigned)_c : ts_lo; ts_hi = (lane == nts) ? (int)(unsigned)(_c >> 32) : ts_hi; ++nts; } } while (0)
    PG8_STAMP();
    unsigned voffA[2], voffB[2];
#pragma unroll
    for (int i = 0; i < 2; ++i) { int R, C; stage_rc(tid * 16 + i * 8192, R, C); const int Rb = Epi::PERM ? ((R & ~31) + perm32(R & 31)) : R;
        voffA[i] = (unsigned)(R * K + C) * 2u; voffB[i] = (unsigned)(Rb * K + C) * 2u; }
    const size_t kstep = (size_t)(BK * 2);
    const size_t hstep = (size_t)HALF * K * 2;
    const size_t tstep = 2 * hstep;
    const unsigned ldsw = (unsigned)wid * 1024u;
    const int aoff = lds_byte(wr * 64 + fr, fq * 8), boff = lds_byte(wc * 32 + fr, fq * 8);
#define PG8_SA(b, h) (((b) * 2 + (h)) * HTB)
#define PG8_SB(b, h) ((4 + (b) * 2 + (h)) * HTB)
#define PG8_STAGE(bufoff, gbase, voff) do { _Pragma("unroll") for (int _i = 0; _i < 2; ++_i) \
        __builtin_amdgcn_global_load_lds((const unsigned*)((const char*)(gbase) + (voff)[_i]), (PG8_LAS unsigned*)(lds + (bufoff) + ldsw + _i * 8192), 16, 0, 0); } while (0)
#define PG8_LDA(dst, b, h) do { _Pragma("unroll") for (int m = 0; m < 4; ++m) _Pragma("unroll") for (int k = 0; k < 2; ++k) dst[m][k] = *(const PG8_LAS bf16x8*)(lds + PG8_SA(b, h) + aoff + m * 2048 + k * 1024); } while (0)
#define PG8_LDB(dst, b, h) do { _Pragma("unroll") for (int n = 0; n < 2; ++n) _Pragma("unroll") for (int k = 0; k < 2; ++k) dst[n][k] = *(const PG8_LAS bf16x8*)(lds + PG8_SB(b, h) + boff + n * 2048 + k * 1024); } while (0)
#define PG8_MMA(ai, bj, At, Bt) do { __builtin_amdgcn_s_setprio(1); _Pragma("unroll") for (int m = 0; m < 4; ++m) _Pragma("unroll") for (int n = 0; n < 2; ++n) _Pragma("unroll") for (int k = 0; k < 2; ++k) \
        acc[ai][bj][m][n] = __builtin_amdgcn_mfma_f32_16x16x32_bf16(Bt[n][k], At[m][k], acc[ai][bj][m][n], 0, 0, 0); __builtin_amdgcn_s_setprio(0); } while (0)
#define PG8_WAIT_V(n) asm volatile("s_waitcnt vmcnt(" #n ")" ::: "memory")
#define PG8_WAIT_L(n) asm volatile("s_waitcnt lgkmcnt(" #n ")" ::: "memory")
#define PG8_BAR __builtin_amdgcn_s_barrier()
#define PG8_SCHED __builtin_amdgcn_sched_barrier(0)
    Unit cur, nxt; int ui = 0;
    if (!S.next(0, cur)) return;
    f32x4 acc[2][2][4][2];
#pragma unroll
    for (int a = 0; a < 2; ++a)
#pragma unroll
        for (int b = 0; b < 2; ++b)
#pragma unroll
            for (int m = 0; m < 4; ++m)
#pragma unroll
                for (int n = 0; n < 2; ++n) acc[a][b][m][n] = (f32x4){0.f, 0.f, 0.f, 0.f};
    bf16x8 At[4][2], B0[2][2], B1[2][2];
    const char* cA = (const char*)g.A + (size_t)cur.pm * tstep; const char* cB = (const char*)g.Bt + (size_t)cur.pn * tstep;
    S.a_ready(cur);
    PG8_STAGE(PG8_SB(0, 0), cB, voffB); PG8_STAGE(PG8_SA(0, 0), cA, voffA); PG8_STAGE(PG8_SB(0, 1), cB + hstep, voffB); PG8_STAGE(PG8_SA(0, 1), cA + hstep, voffA);
    if (wr == 1) PG8_BAR;
    PG8_WAIT_V(4); PG8_BAR;
    PG8_STAGE(PG8_SB(1, 0), cB + kstep, voffB); PG8_STAGE(PG8_SA(1, 0), cA + kstep, voffA); PG8_STAGE(PG8_SB(1, 1), cB + hstep + kstep, voffB);
    PG8_WAIT_V(6); PG8_BAR;
    PG8_STAMP();
    for (;;) {
        const bool has_next = S.next(ui + 1, nxt);
        const char* nA = has_next ? (const char*)g.A + (size_t)nxt.pm * tstep : cA; const char* nB = has_next ? (const char*)g.Bt + (size_t)nxt.pn * tstep : cB;
        for (int t = 0; t < nt; t += 2) {
            const bool last = (t == nt - 2);
            const char* a1 = cA + (size_t)(t + 1) * kstep;
            const char* a2 = last ? nA : cA + (size_t)(t + 2) * kstep; const char* b2 = last ? nB : cB + (size_t)(t + 2) * kstep;
            const char* a3 = a2 + kstep; const char* b3 = b2 + kstep;
            if constexpr (Epi::RESCALE) { if (t == 8 || t == 16) E.rescale(acc, cur, wr, wc, fr, fq, t >> 3); }
            if (last && has_next) S.a_ready(nxt);
            PG8_LDB(B0, 0, 0); PG8_SCHED; PG8_LDA(At, 0, 0); PG8_STAGE(PG8_SA(1, 1), a1 + hstep, voffA);
            PG8_WAIT_L(8); PG8_BAR; PG8_WAIT_L(0); PG8_MMA(0, 0, At, B0); PG8_BAR; PG8_SCHED;
            PG8_LDB(B1, 0, 1); PG8_STAGE(PG8_SB(0, 0), b2, voffB);
            PG8_BAR; PG8_WAIT_L(0); PG8_MMA(0, 1, At, B1); PG8_BAR;
            PG8_LDA(At, 0, 1); PG8_STAGE(PG8_SA(0, 0), a2, voffA);
            PG8_BAR; PG8_WAIT_L(0); PG8_MMA(1, 0, At, B0); PG8_BAR; PG8_SCHED;
            PG8_STAGE(PG8_SB(0, 1), b2 + hstep, voffB);
            PG8_WAIT_V(6); PG8_BAR; PG8_MMA(1, 1, At, B1); PG8_BAR;
            PG8_LDB(B0, 1, 0); PG8_SCHED; PG8_LDA(At, 1, 0); PG8_STAGE(PG8_SA(0, 1), a2 + hstep, voffA);
            PG8_WAIT_L(8); PG8_BAR; PG8_WAIT_L(0); PG8_MMA(0, 0, At, B0); PG8_BAR; PG8_SCHED;
            PG8_LDB(B1, 1, 1); PG8_STAGE(PG8_SB(1, 0), b3, voffB);
            PG8_BAR; PG8_WAIT_L(0); PG8_MMA(0, 1, At, B1); PG8_BAR;
            PG8_LDA(At, 1, 1); PG8_STAGE(PG8_SA(1, 0), a3, voffA);
            PG8_BAR; PG8_WAIT_L(0); PG8_MMA(1, 0, At, B0); PG8_BAR; PG8_SCHED;
            PG8_STAGE(PG8_SB(1, 1), b3 + hstep, voffB);
            PG8_WAIT_V(6); PG8_BAR; PG8_MMA(1, 1, At, B1); PG8_BAR;
        }
        PG8_STAMP();
        if constexpr (!Epi::AFTER_DRAIN) { E(acc, cur, wr, wc, fr, fq); S.done(cur); }
        PG8_STAMP();
        if (!has_next) break;
#pragma unroll
        for (int a = 0; a < 2; ++a)
#pragma unroll
            for (int b = 0; b < 2; ++b)
#pragma unroll
                for (int m = 0; m < 4; ++m)
#pragma unroll
                    for (int n = 0; n < 2; ++n) acc[a][b][m][n] = (f32x4){0.f, 0.f, 0.f, 0.f};
        cur = nxt; cA = nA; cB = nB; ++ui;
    }
    PG8_WAIT_V(0);
    if (wr == 0) PG8_BAR;
    PG8_BAR;
    if constexpr (Epi::AFTER_DRAIN) { E.fused(acc, cur, wr, wc, fr, fq, lds, wid, lane); S.done(cur); }
    PG8_STAMP();
    if (STAMP && wid == 0) { stamps[lane] = lane < nts ? (((unsigned long long)(unsigned)ts_hi << 32) | (unsigned)ts_lo) : 0ull;
        if (lane == 62) stamps[62] = rt_entry; if (lane == 63) stamps[63] = (unsigned long long)wall_clock64(); }
#undef PG8_STAMP
#undef PG8_SA
#undef PG8_SB
#undef PG8_STAGE
#undef PG8_LDA
#undef PG8_LDB
#undef PG8_MMA
#undef PG8_WAIT_V
#undef PG8_WAIT_L
#undef PG8_BAR
#undef PG8_SCHED
}
}


__device__ __forceinline__ void gemm_loop(const u16* __restrict__ A, long lda, const u16* __restrict__ W, long ldw,
                                          int K, char* smem, f32x4 (&acc)[4][4]) {
  const int t = TID(), lane = t & 63, w = t >> 6, wm = w & 3, wn = w >> 2;
  const int lr = t >> 3, kc = (t & 7) * 8;
  u16* sA = (u16*)smem;
  u16* sW = sA + 256 * 72;
  const u16* ga = A + (long)lr * lda + kc;
  const u16* gw = W + (long)lr * ldw + kc;
  u32x4 ra[4], rw[2];
#pragma unroll
  for (int i = 0; i < 4; ++i) ra[i] = *(const u32x4*)(ga + (long)(64 * i) * lda);
#pragma unroll
  for (int i = 0; i < 2; ++i) rw[i] = *(const u32x4*)(gw + (long)(64 * i) * ldw);
  const int fr = lane & 15, fq = (lane >> 4) * 8;
  for (int k0 = 0; k0 < K; k0 += 64) {
    __syncthreads();
#pragma unroll
    for (int i = 0; i < 4; ++i) *(u32x4*)(sA + (lr + 64 * i) * 72 + kc) = ra[i];
#pragma unroll
    for (int i = 0; i < 2; ++i) *(u32x4*)(sW + (lr + 64 * i) * 72 + kc) = rw[i];
    __syncthreads();
    if (k0 + 64 < K) {
#pragma unroll
      for (int i = 0; i < 4; ++i) ra[i] = *(const u32x4*)(ga + (long)(64 * i) * lda + k0 + 64);
#pragma unroll
      for (int i = 0; i < 2; ++i) rw[i] = *(const u32x4*)(gw + (long)(64 * i) * ldw + k0 + 64);
    }
#pragma unroll
    for (int ks = 0; ks < 2; ++ks) {
      bf16x8 fa[4], fw[4];
#pragma unroll
      for (int i = 0; i < 4; ++i) fw[i] = ldfrag(sW, wn * 64 + i * 16 + fr, 72, ks * 32 + fq);
#pragma unroll
      for (int j = 0; j < 4; ++j) fa[j] = ldfrag(sA, wm * 64 + j * 16 + fr, 72, ks * 32 + fq);
#pragma unroll
      for (int i = 0; i < 4; ++i)
#pragma unroll
        for (int j = 0; j < 4; ++j) acc[i][j] = MFMA(fw[i], fa[j], acc[i][j]);
    }
  }
}
__device__ __forceinline__ void zero_acc(f32x4 (&acc)[4][4]) {
#pragma unroll
  for (int i = 0; i < 4; ++i)
#pragma unroll
    for (int j = 0; j < 4; ++j) acc[i][j] = f32x4{0.f, 0.f, 0.f, 0.f};
}
#define EPI_LOOP(...)                                                         \
  {                                                                           \
    const int _t = TID(), _lane = _t & 63, _w = _t >> 6;                \
    const int _wm = _w & 3, _wn = _w >> 2;                                    \
    _Pragma("unroll") for (int _i = 0; _i < 4; ++_i)                          \
    _Pragma("unroll") for (int _j = 0; _j < 4; ++_j) {                        \
      const int ml = _wm * 64 + _j * 16 + (_lane & 15);                       \
      const int nl = _wn * 64 + _i * 16 + (_lane >> 4) * 4;                   \
      f32x4 v = acc[_i][_j];                                                  \
      __VA_ARGS__                                                             \
    }                                                                         \
  }

__device__ __forceinline__ int mod_idx(int r) { return r < MLAT ? (r >> 12) : 8; }

struct S5c { float lr, li, dt; };
__device__ __forceinline__ S5c s5_load(const P& p, int l, int dir, int g, int s) {
  S5c c;
  float lre = lptr(p.in[14])[((l * 2 + dir) * 32 + g) * 64 + s];
  c.lr = fminf(lre, -1e-4f);
  c.li = lptr(p.in[15])[((l * 2 + dir) * 32 + g) * 64 + s];
  c.dt = expf(lptr(p.in[16])[(l * 2 + dir) * 32 + g]);
  return c;
}
__device__ __forceinline__ void s5_pow(const S5c& c, int j, float& re, float& im) {
  float mag = expf(c.lr * c.dt * (float)j);
  float th = c.li * c.dt;
  th -= 6.283185307179586f * rintf(th * 0.15915494309189535f);
  float ang = th * (float)j;
  float sn, cs;
  sincosf(ang, &sn, &cs);
  re = mag * cs;
  im = mag * sn;
}
__device__ __forceinline__ void s5_coef(const S5c& c, float& cr, float& ci) {
  float ar, ai;
  s5_pow(c, 1, ar, ai);
  float den = c.lr * c.lr + c.li * c.li;
  cr = ((ar - 1.0f) * c.lr + ai * c.li) / den;
  ci = (ai * c.lr - (ar - 1.0f) * c.li) / den;
}


__device__ __forceinline__ void ph_init(const P& p, int item, char* smem) {
  const int t = TID();
  if (item < 192) {
    const int l = item / 96, nb = item % 96;
    float* sc = (float*)smem;
    float* part = sc + 9 * 1024;
    __syncthreads();
    for (int e = t; e < 9 * 1024; e += NT) {
      int r = e >> 10, k = e & 1023;
      float cv = r < 8 ? lptr(p.in[1])[r * 1024 + k] : lptr(p.in[3])[k];
      sc[e] = siluf(cv);
    }
    __syncthreads();
    const int col = t & 63, kg = t >> 6;
    const float* wp = lptr(p.in[4]) + (size_t)l * 1024 * 6144 + nb * 64 + col;
    float a[9];
#pragma unroll
    for (int r = 0; r < 9; ++r) a[r] = 0.f;
    for (int k = kg * 128; k < kg * 128 + 128; ++k) {
      float wv = wp[(size_t)k * 6144];
#pragma unroll
      for (int r = 0; r < 9; ++r) a[r] += sc[r * 1024 + k] * wv;
    }
#pragma unroll
    for (int r = 0; r < 9; ++r) part[(kg * 9 + r) * 64 + col] = a[r];
    __syncthreads();
    float* mods = (float*)(lptr(p.ws) + OFF_MODS);
    for (int e = t; e < 9 * 64; e += NT) {
      int r = e >> 6, c2 = e & 63;
      float s = 0.f;
      for (int g2 = 0; g2 < 8; ++g2) s += part[(g2 * 9 + r) * 64 + c2];
      int n = nb * 64 + c2;
      mods[(l * 9 + r) * 6144 + n] = s + lptr(p.in[5])[l * 6144 + n];
    }
  } else if (item < 448) {
    const int it = item - 192;
    const float4* src = (const float4*)lptr(p.in[2]);
    float4* dst = (float4*)(lptr(p.ws) + OFF_XC);
#pragma unroll
    for (int i = 0; i < 4; ++i) dst[(size_t)it * 2048 + i * 512 + t] = src[(size_t)it * 2048 + i * 512 + t];
  } else {
    float* lb = (float*)(lptr(p.ws) + OFF_LB);
    for (int e = t; e < 1024; e += NT) {
      float l0 = lptr(p.in[8])[e], l1 = lptr(p.in[8])[1024 + e];
      float m = fmaxf(l0, l1);
      float e0 = expf(l0 - m), e1 = expf(l1 - m);
      lb[e] = 0.f;
      lb[1024 + e] = e1 / (e0 + e1);
    }
  }
}

__device__ __forceinline__ void transpose_tile(const float* __restrict__ src, int Nsrc, u16* __restrict__ dst, int K, int tn, int tk4,
                               bool win_map, char* smem, int ldd = 0, int koff = 0) {
  if (ldd == 0) ldd = K;
  float* tile = (float*)smem;
  const int t = TID(), tx = t & 63, ty = t >> 6;
  __syncthreads();
  int np = tn * 64 + tx;
  int sc = np;
  bool zero = false;
  if (win_map) {
    if (np >= 4864) sc = np - 240;
    else if (np >= 4624) zero = true;
  }
  float v[32];
#pragma unroll
  for (int i = 0; i < 32; ++i) {
    int kk = ty + 8 * i;
    v[i] = zero ? 0.f : src[(size_t)(tk4 * 256 + kk) * Nsrc + sc];
  }
#pragma unroll
  for (int i = 0; i < 32; ++i) tile[tx * 257 + ty + 8 * i] = v[i];
  __syncthreads();
#pragma unroll
  for (int i = 0; i < 8; ++i) {
    int nn = ty + 8 * i;
#pragma unroll
    for (int j = 0; j < 2; ++j) {
      int kk = 2 * tx + 128 * j;
      *(unsigned*)(dst + (size_t)(tn * 64 + nn) * ldd + koff + tk4 * 256 + kk) = pack2(tile[nn * 257 + kk], tile[nn * 257 + kk + 1]);
    }
  }
}

__device__ __forceinline__ void norm_rows(const P& p, int l, int item, int which) {
  const int t = TID(), lane = t & 63, w = t >> 6;
  const float* nw = (which == 0 ? lptr(p.in[6]) : lptr(p.in[27])) + l * 1024;
  float4 v[2][4];
  float ss[2];
#pragma unroll
  for (int q = 0; q < 2; ++q) {
    const int r = item * 16 + w * 2 + q;
    const float* xr;
    if (r < MLAT) xr = ((which == 0 && l == 0) ? lptr(p.in[0]) : lptr(p.out)) + (size_t)r * 1024;
    else xr = (const float*)(lptr(p.ws) + OFF_XC) + (size_t)(r - MLAT) * 1024;
#pragma unroll
    for (int i = 0; i < 4; ++i) v[q][i] = *(const float4*)(xr + i * 256 + lane * 4);
  }
#pragma unroll
  for (int q = 0; q < 2; ++q) {
    float a = 0.f;
#pragma unroll
    for (int i = 0; i < 4; ++i) a += v[q][i].x * v[q][i].x + v[q][i].y * v[q][i].y + v[q][i].z * v[q][i].z + v[q][i].w * v[q][i].w;
    ss[q] = wsum(a);
  }
#pragma unroll
  for (int q = 0; q < 2; ++q) {
    const int r = item * 16 + w * 2 + q;
    const float* mods = (const float*)(lptr(p.ws) + OFF_MODS) + (size_t)(l * 9 + mod_idx(r)) * 6144;
    const float* sh = mods + (which == 0 ? 0 : 3) * 1024;
    const float* scl = mods + (which == 0 ? 1 : 4) * 1024;
    float rstd = rsqrtf(ss[q] * (1.f / 1024.f) + 1e-6f);
    u16* H = (u16*)(lptr(p.ws) + OFF_H) + (size_t)r * 1024;
#pragma unroll
    for (int i = 0; i < 4; ++i) {
      int c = i * 256 + lane * 4;
      float4 wv = *(const float4*)(nw + c), s1 = *(const float4*)(sh + c), s2 = *(const float4*)(scl + c);
      f32x4 o;
      o[0] = v[q][i].x * rstd * wv.x * (1.f + s2.x) + s1.x;
      o[1] = v[q][i].y * rstd * wv.y * (1.f + s2.y) + s1.y;
      o[2] = v[q][i].z * rstd * wv.z * (1.f + s2.z) + s1.z;
      o[3] = v[q][i].w * rstd * wv.w * (1.f + s2.w) + s1.w;
      *(uint2*)(H + c) = pack4(o);
    }
  }
}

__device__ __forceinline__ void s5_ktable(const P& p, int l, int item, char* smem) {
  const int t = TID();
  const int jb = item & 7, g = (item >> 3) & 31, dir = item >> 8;
  float2* pwB = (float2*)smem;
  float2* Cc = pwB + 8192;
  float2* pc = Cc + 1024;
  __syncthreads();
  {
    int s0 = t & 63, jj = t >> 6;
    S5c c = s5_load(p, l, dir, g, s0);
    float pr, pi, cr, ci;
    s5_pow(c, jb * 8 + jj, pr, pi);
    s5_coef(c, cr, ci);
    pc[t] = float2{pr * cr - pi * ci, pr * ci + pi * cr};
  }
#pragma unroll 1
  for (int e = t; e < 1024; e += NT) {
    int co = e >> 6, s2 = e & 63;
    Cc[e] = float2{lptr(p.in[19])[((size_t)(l * 32 + g) * 16 + co) * 64 + s2], lptr(p.in[20])[((size_t)(l * 32 + g) * 16 + co) * 64 + s2]};
  }
  __syncthreads();
#pragma unroll 1
  for (int e = t; e < 1024; e += NT) {
    int s = e >> 4;
    float br = lptr(p.in[17])[((size_t)(l * 32 + g) * 64) * 16 + e];
    float bi = lptr(p.in[18])[((size_t)(l * 32 + g) * 64) * 16 + e];
#pragma unroll
    for (int jj = 0; jj < 8; ++jj) {
      float2 q = pc[jj * 64 + s];
      pwB[jj * 1024 + e] = float2{q.x * br - q.y * bi, q.x * bi + q.y * br};
    }
  }
  __syncthreads();
  float* KT = (float*)(lptr(p.ws) + OFF_KT);
#pragma unroll 1
  for (int o = t; o < 2048; o += NT) {
    int jj = o >> 8, cc = o & 255, co = cc >> 4, ci2 = cc & 15;
    float acc = 0.f;
#pragma unroll 8
    for (int s = 0; s < 64; ++s) {
      float2 c = Cc[co * 64 + s], b = pwB[jj * 1024 + s * 16 + ci2];
      acc += c.x * b.x - c.y * b.y;
    }
    KT[((size_t)((dir * 32 + g) * 64 + jb * 8 + jj)) * 256 + cc] = acc;
  }
}

__device__ __forceinline__ void ph_start(const P& p, int l, int item, char* smem) {
  u16* WT = (u16*)(lptr(p.ws) + OFF_WT);
  if (item < 1216) {
    int it = item;
    if (it < 528) { transpose_tile(lptr(p.in[7]) + (size_t)l * 1024 * 8208, 8208, WT + W_IN, 1024, it >> 2, it & 3, true, smem); return; }
    it -= 528;
    if (it < 256) { transpose_tile(lptr(p.in[28]) + (size_t)l * 1024 * 4096, 4096, WT + W_FF1, 1024, it >> 2, it & 3, false, smem); return; }
    it -= 256;
    if (it < 256) { transpose_tile(lptr(p.in[29]) + (size_t)l * 4096 * 1024, 1024, WT + W_FF2, 4096, it >> 4, it & 15, false, smem); return; }
    it -= 256;
    if (it < 64) { transpose_tile(lptr(p.in[26]) + (size_t)l * 1024 * 1024, 1024, WT + W_O, 1024, it >> 2, it & 3, false, smem); return; }
    it -= 64;
    if (it < 96) {
      int which = it >> 5, ii = it & 31;
      const float* src = lptr(p.in[23 + which]) + (size_t)l * 512 * 1024;
      transpose_tile(src, 1024, WT + W_BA, 512, ii >> 1, ii & 1, false, smem, 1536, which * 512);
      return;
    }
    it -= 96;
    transpose_tile(lptr(p.in[22]) + (size_t)l * 512 * 512, 512, WT + W_GLU, 512, it >> 1, it & 1, false, smem);
    return;
  }
  item -= 1216;
  if (item < 2176) { norm_rows(p, l, item, 0); return; }
  item -= 2176;
  s5_ktable(p, l, item, smem);
}

__device__ __forceinline__ void prep_a(const P& p, int l, char* smem) {
  const int t = TID(), lane = t & 63, w = t >> 6;
  u16* qh = (u16*)smem;
  u16* kh = qh + 64 * 136;
  u16* ktl = kh + 64 * 136;
  u16* vT = ktl + 128 * 72;
  u16* at = vT + 128 * 72;
  float* tot = (float*)(at + 64 * 72);
  float* c31 = tot + 512;
  float* lst = c31 + 128;
  u16* PA = (u16*)(lptr(p.ws) + OFF_R + R_PA);
  u16* NX = (u16*)(lptr(p.ws) + OFF_NA);
  float* EL = (float*)(lptr(p.ws) + OFF_BA);
  const int d = t & 127, qtr = t >> 7;
  const int fr = lane & 15, fq = lane >> 4;
  u16 zr[16], qr[16];
  u32x4 pv0, pv1;
#define ISSUE_P(jj)                                                                             \
  {                                                                                             \
    const int it_ = (int)blockIdx.x + ((jj) >> 1) * (int)gridDim.x, dir_ = (jj) & 1;            \
    const int cn_ = it_ % 68, h_ = (it_ / 68) & 3, b_ = it_ / 272;                              \
    const int cs_ = dir_ == 0 ? cn_ : (cn_ < 4 ? 3 - cn_ : 71 - cn_);                           \
    _Pragma("unroll") for (int i = 0; i < 16; ++i) {                                            \
      int row_ = chain_row(b_, dir_, cs_, qtr * 16 + i);                                        \
      const u16* pr_ = PA + (size_t)row_ * 2560;                                                \
      zr[i] = pr_[1024 + dir_ * 512 + h_ * 128 + d];                                            \
      qr[i] = pr_[h_ * 128 + d];                                                                \
    }                                                                                           \
    int rowv_ = chain_row(b_, dir_, cs_, t >> 3);                                               \
    const u32x4* vp_ = (const u32x4*)(PA + (size_t)rowv_ * 2560 + 512 + h_ * 128 + (t & 7) * 16); \
    pv0 = vp_[0]; pv1 = vp_[1];                                                                 \
  }
  const int nj = ((2176 - (int)blockIdx.x + (int)gridDim.x - 1) / (int)gridDim.x) * 2;
  if (nj > 0) ISSUE_P(0)
#pragma unroll 1
  for (int j = 0; j < nj; ++j) {
    const int item = (int)blockIdx.x + (j >> 1) * (int)gridDim.x, dir = j & 1;
    const int cnat = item % 68, h = (item / 68) & 3, b = item / 272;
    const int rbase = cnat < 4 ? MLAT + b * 256 + cnat * 64 : b * 4096 + (cnat - 4) * 64;
    const int cstep = dir == 0 ? cnat : (cnat < 4 ? 3 - cnat : 71 - cnat);
    const float lbv = ((const float*)(lptr(p.ws) + OFF_LB))[(l * 2 + dir) * 512 + h * 128 + d];
    u16* OUT = (u16*)(lptr(p.ws) + OFF_R + (dir == 0 ? R_OF : R_OB));
    float cum[16], qv[16], kv[16];
    LDS_SYNC();
    {
      float run = 0.f;
#pragma unroll
      for (int i = 0; i < 16; ++i) {
        float z = bf2f(zr[i]);
        float f = lbv + (1.f - lbv) * sigm(z);
        run += __logf(f);
        cum[i] = run;
        kv[i] = 1.f - f;
        qv[i] = siluf(bf2f(qr[i]));
      }
      tot[qtr * 128 + d] = run;
    }
    {
      int sg = t >> 3, v0 = (t & 7) * 16;
      u32x4 a0 = pv0, a1 = pv1;
#pragma unroll
      for (int i = 0; i < 4; ++i) {
        vT[(v0 + 2 * i) * 72 + sg] = (u16)(a0[i] & 0xffff);
        vT[(v0 + 2 * i + 1) * 72 + sg] = (u16)(a0[i] >> 16);
        vT[(v0 + 8 + 2 * i) * 72 + sg] = (u16)(a1[i] & 0xffff);
        vT[(v0 + 8 + 2 * i + 1) * 72 + sg] = (u16)(a1[i] >> 16);
      }
    }
    if (j + 1 < nj) ISSUE_P(j + 1)
    LDS_SYNC();
    {
      float off = 0.f;
      for (int q2 = 0; q2 < qtr; ++q2) off += tot[q2 * 128 + d];
#pragma unroll
      for (int i = 0; i < 16; ++i) cum[i] += off;
      if (qtr == 1) c31[d] = cum[15];
      if (qtr == 3) lst[d] = cum[15];
    }
    LDS_SYNC();
    {
      float cm = c31[d], la = lst[d];
      float ecm = __expf(cm), elc = __expf(la - cm);
      if (qtr == 3) EL[((size_t)(((dir * 8 + b) * 4 + h) * 68 + cstep)) * 128 + d] = __expf(la);
#pragma unroll
      for (int i = 0; i < 16; ++i) {
        int tau = qtr * 16 + i;
        float qhat = qv[i] * __expf(cum[i] - cm);
        float khat = kv[i] * __expf(cm - cum[i]);
        qh[tau * 136 + d] = f2bf(qhat);
        kh[tau * 136 + d] = f2bf(khat);
        ktl[d * 72 + tau] = f2bf(khat * elc);
        int row = chain_row(b, dir, cstep, tau);
        PA[(size_t)row * 2560 + 1024 + dir * 512 + h * 128 + d] = f2bf(qhat * ecm);
      }
    }
    LDS_SYNC();
    {
      int dd = t >> 2, s0 = (t & 3) * 16;
      u32x4 a0 = *(const u32x4*)(ktl + dd * 72 + s0), a1 = *(const u32x4*)(ktl + dd * 72 + s0 + 8);
      u16* dst = NX + (size_t)(rbase + (t >> 3)) * 1536 + 512 + dir * 512 + h * 128 + (t & 7) * 16;
      *(u32x4*)dst = a0;
      *(u32x4*)(dst + 8) = a1;
    }
    {
      int tt = w >> 1;
#pragma unroll
      for (int u = 0; u < 2; ++u) {
        int st = (w & 1) * 2 + u;
        f32x4 a = f32x4{0.f, 0.f, 0.f, 0.f};
        if (st <= tt) {
#pragma unroll
          for (int ks = 0; ks < 4; ++ks)
            a = MFMA(ldfrag(kh, st * 16 + fr, 136, ks * 32 + fq * 8), ldfrag(qh, tt * 16 + fr, 136, ks * 32 + fq * 8), a);
          int tau = tt * 16 + fr;
#pragma unroll
          for (int r = 0; r < 4; ++r) {
            int sg = st * 16 + fq * 4 + r;
            if (sg > tau) a[r] = 0.f;
          }
        }
        *(uint2*)(at + (tt * 16 + fr) * 72 + st * 16 + fq * 4) = pack4(a);
      }
    }
    LDS_SYNC();
    {
      int tt = w >> 1;
      int row = chain_row(b, dir, cstep, tt * 16 + fr);
#pragma unroll
      for (int u = 0; u < 4; ++u) {
        int vt = (w & 1) * 4 + u;
        f32x4 a = f32x4{0.f, 0.f, 0.f, 0.f};
#pragma unroll
        for (int ks = 0; ks < 2; ++ks)
          a = MFMA(ldfrag(vT, vt * 16 + fr, 72, ks * 32 + fq * 8), ldfrag(at, tt * 16 + fr, 72, ks * 32 + fq * 8), a);
        *(uint2*)(OUT + (size_t)row * 512 + h * 128 + vt * 16 + fq * 4) = pack4(a);
      }
    }
  }
}
#undef ISSUE_P

__device__ __forceinline__ void chain_a(const P& p, int l, int item, char* smem) {
  const int t = TID(), lane = t & 63, w = t >> 6;
  const int vs = (item >> 3) & 3, chn = ((item >> 5) << 3) | (item & 7), dir = chn & 1, h = (chn >> 1) & 3, b = chn >> 3;
  u16* qh = (u16*)smem;
  u16* khT = qh + 64 * 136;
  u16* vT = khT + 128 * 72;
  u16* sT = vT + 32 * 72;
  float* lst = (float*)(sT + 32 * 136);
  const u16* PA = (const u16*)(lptr(p.ws) + OFF_R + R_PA);
  const u16* NX = (const u16*)(lptr(p.ws) + OFF_NA);
  const float* EL = (const float*)(lptr(p.ws) + OFF_BA);
  u16* OUT = (u16*)(lptr(p.ws) + OFF_R + (dir == 0 ? R_OF : R_OB));
  const int fr = lane & 15, fq = lane >> 4;
  const int vt = w & 1, tt = w >> 1;
  f32x4 S[2];
  S[0] = f32x4{0.f, 0.f, 0.f, 0.f};
  S[1] = S[0];
  u32x4 pq0, pq1, pk0, pk1;
  unsigned pv0, pv1, po0, po1;
  float pel = 0.f;
#define ISSUE_A(cc)                                                                               \
  {                                                                                               \
    int row = chain_row(b, dir, (cc), t >> 3);                                                    \
    const u16* sq = PA + (size_t)row * 2560 + 1024 + dir * 512 + h * 128 + (t & 7) * 16;          \
    pq0 = *(const u32x4*)sq; pq1 = *(const u32x4*)(sq + 8);                                       \
    const unsigned* vp = (const unsigned*)(PA + (size_t)row * 2560 + 512 + h * 128 + vs * 32 + (t & 7) * 4); \
    pv0 = vp[0]; pv1 = vp[1];                                                                     \
    int cn = dir == 0 ? (cc) : ((cc) < 4 ? 3 - (cc) : 71 - (cc));                                 \
    int rb = cn < 4 ? MLAT + b * 256 + cn * 64 : b * 4096 + (cn - 4) * 64;                        \
    const u16* sk = NX + (size_t)(rb + (t >> 3)) * 1536 + 512 + dir * 512 + h * 128 + (t & 7) * 16; \
    pk0 = *(const u32x4*)sk; pk1 = *(const u32x4*)(sk + 8);                                       \
    int orow = chain_row(b, dir, (cc), tt * 16 + fr);                                             \
    const unsigned* op = (const unsigned*)(OUT + (size_t)orow * 512 + h * 128 + vs * 32 + vt * 16 + fq * 4); \
    po0 = op[0]; po1 = op[1];                                                                     \
    if (t < 128) pel = EL[((size_t)(((dir * 8 + b) * 4 + h) * 68 + (cc))) * 128 + t];             \
  }
  ISSUE_A(0)
  for (int c = 0; c < 68; ++c) {
    LDS_SYNC();
    {
      int tau = t >> 3, d0 = (t & 7) * 16;
      *(u32x4*)(qh + tau * 136 + d0) = pq0;
      *(u32x4*)(qh + tau * 136 + d0 + 8) = pq1;
      int dd = t >> 2, s0 = (t & 3) * 16;
      *(u32x4*)(khT + dd * 72 + s0) = pk0;
      *(u32x4*)(khT + dd * 72 + s0 + 8) = pk1;
      int v4 = (t & 7) * 4;
      vT[(v4 + 0) * 72 + tau] = (u16)(pv0 & 0xffff);
      vT[(v4 + 1) * 72 + tau] = (u16)(pv0 >> 16);
      vT[(v4 + 2) * 72 + tau] = (u16)(pv1 & 0xffff);
      vT[(v4 + 3) * 72 + tau] = (u16)(pv1 >> 16);
      if (t < 128) lst[t] = pel;
#pragma unroll
      for (int v2 = 0; v2 < 2; ++v2) *(uint2*)(sT + (v2 * 16 + fr) * 136 + w * 16 + fq * 4) = pack4(S[v2]);
    }
    const unsigned oi0 = po0, oi1 = po1;
    const int crow = chain_row(b, dir, c, tt * 16 + fr);
    LDS_SYNC();
    if (c + 1 < 68) ISSUE_A(c + 1)
    {
      f32x4 a = f32x4{0.f, 0.f, 0.f, 0.f};
#pragma unroll
      for (int ks = 0; ks < 4; ++ks)
        a = MFMA(ldfrag(sT, vt * 16 + fr, 136, ks * 32 + fq * 8), ldfrag(qh, tt * 16 + fr, 136, ks * 32 + fq * 8), a);
      a[0] += bf2f((u16)(oi0 & 0xffff));
      a[1] += bf2f((u16)(oi0 >> 16));
      a[2] += bf2f((u16)(oi1 & 0xffff));
      a[3] += bf2f((u16)(oi1 >> 16));
      *(uint2*)(OUT + (size_t)crow * 512 + h * 128 + vs * 32 + vt * 16 + fq * 4) = pack4(a);
#pragma unroll
      for (int v2 = 0; v2 < 2; ++v2) {
        f32x4 ds = f32x4{0.f, 0.f, 0.f, 0.f};
#pragma unroll
        for (int ks = 0; ks < 2; ++ks)
          ds = MFMA(ldfrag(khT, w * 16 + fr, 72, ks * 32 + fq * 8), ldfrag(vT, v2 * 16 + fr, 72, ks * 32 + fq * 8), ds);
#pragma unroll
        for (int r = 0; r < 4; ++r) S[v2][r] = lst[w * 16 + fq * 4 + r] * S[v2][r] + ds[r];
      }
    }
  }
}
#undef ISSUE_A

__device__ __forceinline__ void normgate(const P& p, int l, int item, int which) {
  const int t = TID(), lane = t & 63, w = t >> 6;
  const int row0 = item * 16 + w * 2;
  char* R = lptr(p.ws) + OFF_R;
  const u16 *ofb, *obb, *gtb;
  int so, sg;
  const float* nw;
  u16* outb;
  if (which == 0) {
    ofb = (const u16*)(R + R_OF); obb = (const u16*)(R + R_OB); so = 512;
    gtb = (const u16*)(R + R_PA) + 2048; sg = 2560;
    nw = lptr(p.in[9]) + l * 128;
    outb = (u16*)(lptr(p.ws) + OFF_NA);
  } else {
    ofb = (const u16*)(R + R_PB) + 512; obb = (const u16*)(R + R_PB) + 1024; so = 2304;
    gtb = (const u16*)(R + R_PB) + 1536; sg = 2304;
    nw = lptr(p.in[13]) + l * 128;
    outb = (u16*)(lptr(p.ws) + OFF_NA) + 512;
  }
  unsigned a[2][4], bb[2][4], g[2][4];
#pragma unroll
  for (int r = 0; r < 2; ++r)
#pragma unroll
    for (int h = 0; h < 4; ++h) {
      int c = h * 128 + lane * 2;
      a[r][h] = *(const unsigned*)(ofb + (size_t)(row0 + r) * so + c);
      bb[r][h] = *(const unsigned*)(obb + (size_t)(row0 + r) * so + c);
      g[r][h] = *(const unsigned*)(gtb + (size_t)(row0 + r) * sg + c);
    }
  const float w0 = nw[lane * 2], w1 = nw[lane * 2 + 1];
#pragma unroll
  for (int r = 0; r < 2; ++r)
#pragma unroll
    for (int h = 0; h < 4; ++h) {
      float o0 = bf2f((u16)(a[r][h] & 0xffff)) + bf2f((u16)(bb[r][h] & 0xffff));
      float o1 = bf2f((u16)(a[r][h] >> 16)) + bf2f((u16)(bb[r][h] >> 16));
      float ss = wsum(o0 * o0 + o1 * o1);
      float rstd = rsqrtf(ss * (1.f / 128.f) + 1e-6f);
      float g0 = bf2f((u16)(g[r][h] & 0xffff)), g1 = bf2f((u16)(g[r][h] >> 16));
      *(unsigned*)(outb + (size_t)(row0 + r) * 1536 + h * 128 + lane * 2) = pack2(o0 * rstd * w0 * siluf(g0), o1 * rstd * w1 * siluf(g1));
    }
}

__device__ __forceinline__ void conv_b(const P& p, int l, int item) {
  const int t = TID(), lane = t & 63, w = t >> 6;
  const int u = item * 8 + w;
  const int tile = u / 12, slot = u % 12;
  const u16* PB = (const u16*)(lptr(p.ws) + OFF_R + R_PB);
  u16* Q = (u16*)(lptr(p.ws) + OFF_R + R_QKV);
  const int row0 = tile * 16;
  int pos0, len;
  if (row0 < MLAT) { pos0 = row0 & 4095; len = 4096; }
  else { pos0 = (row0 - MLAT) & 255; len = 256; }
  const int ch = slot * 128 + lane * 2;
  const float* cw = lptr(p.in[10]) + (size_t)l * 5 * 1536;
  float w0[5], w1[5];
#pragma unroll
  for (int j = 0; j < 5; ++j) { w0[j] = cw[j * 1536 + ch]; w1[j] = cw[j * 1536 + ch + 1]; }
  unsigned raw[20];
#pragma unroll
  for (int i = 0; i < 20; ++i) {
    int pp = pos0 + i - 2;
    raw[i] = (pp >= 0 && pp < len) ? *(const unsigned*)(PB + (size_t)(row0 + i - 2) * 2304 + ch) : 0u;
  }
#pragma unroll
  for (int i = 0; i < 16; ++i) {
    float a0 = 0.f, a1 = 0.f;
#pragma unroll
    for (int j = 0; j < 5; ++j) {
      a0 += w0[j] * bf2f((u16)(raw[i + j] & 0xffff));
      a1 += w1[j] * bf2f((u16)(raw[i + j] >> 16));
    }
    a0 = siluf(a0);
    a1 = siluf(a1);
    if (slot < 8) {
      float ss = wsum(a0 * a0 + a1 * a1);
      float sc = rsqrtf(ss + 1e-6f);
      if (slot < 4) sc *= 0.08838834764831845f;
      a0 *= sc;
      a1 *= sc;
    }
    *(unsigned*)(Q + (size_t)(row0 + i) * 1536 + ch) = pack2(a0, a1);
  }
}

__device__ __forceinline__ void gdn_bg(const P& p, int l, int row, int dir, int h, float& beta, float& g) {
  const float* BA = (const float*)(lptr(p.ws) + OFF_BA) + (size_t)row * 16;
  beta = sigm(BA[dir * 4 + h]);
  float a = BA[8 + dir * 4 + h] + lptr(p.in[12])[(l * 2 + dir) * 4 + h];
  float sp = a > 20.f ? a : log1pf(expf(a));
  g = -expf(lptr(p.in[11])[(l * 2 + dir) * 4 + h]) * sp;
}

__device__ __forceinline__ void tphase_b(const P& p, int l, char* smem) {
  const int t = TID(), lane = t & 63, w = t >> 6;
  u16* ks = (u16*)smem;
  float* Am = (float*)(ks + 64 * 136);
  float* Tm = Am + 64 * 68;
  float* Wm = Tm + 64 * 68;
  float* cumL = Wm + 16 * 68;
  float* betL = cumL + 64;
  const u16* Q = (const u16*)(lptr(p.ws) + OFF_R + R_QKV);
  u16* PB = (u16*)(lptr(p.ws) + OFF_R + R_PB);
  float* BAw = (float*)(lptr(p.ws) + OFF_BA);
  u32x4 pa0, pa1;
  float pbeta = 0.f, pav = 0.f;
#define ISSUE_T(it)                                                                          \
  {                                                                                          \
    const int c_ = (it) % 68, rest_ = (it) / 68;                                             \
    const int dir_ = rest_ & 1, h_ = (rest_ >> 1) & 3, b_ = rest_ >> 3;                      \
    int row_ = chain_row(b_, dir_, c_, t >> 3);                                              \
    const u16* src_ = Q + (size_t)row_ * 1536 + 512 + h_ * 128 + (t & 7) * 16;               \
    pa0 = *(const u32x4*)src_; pa1 = *(const u32x4*)(src_ + 8);                              \
    if (t < 64) {                                                                            \
      int rowt_ = chain_row(b_, dir_, c_, t);                                                \
      pbeta = BAw[(size_t)rowt_ * 16 + dir_ * 4 + h_];                                       \
      pav = BAw[(size_t)rowt_ * 16 + 8 + dir_ * 4 + h_];                                     \
    }                                                                                        \
  }
  int item = blockIdx.x;
  if (item < 4352) ISSUE_T(item)
#pragma unroll 1
  for (; item < 4352; item += gridDim.x) {
  const int c = item % 68;
  const int rest = item / 68;
  const int dir = rest & 1, h = (rest >> 1) & 3, b = rest >> 3;
  LDS_SYNC();
  {
    int tau = t >> 3, d0 = (t & 7) * 16;
    *(u32x4*)(ks + tau * 136 + d0) = pa0;
    *(u32x4*)(ks + tau * 136 + d0 + 8) = pa1;
  }
  for (int e = t; e < 64 * 68; e += NT) Tm[e] = 0.f;
  if (t < 64) {
    int row = chain_row(b, dir, c, t);
    float beta = sigm(pbeta);
    float av = pav + lptr(p.in[12])[(l * 2 + dir) * 4 + h];
    float ex = __expf(av);
    float sp = av > 20.f ? av : (ex < 1e-3f ? ex * (1.f - 0.5f * ex) : __logf(1.f + ex));
    float g = -expf(lptr(p.in[11])[(l * 2 + dir) * 4 + h]) * sp;
    float cs = g;
#pragma unroll
    for (int o = 1; o < 64; o <<= 1) {
      float n = __shfl_up(cs, o, 64);
      if (lane >= o) cs += n;
    }
    cumL[t] = cs;
    betL[t] = beta;
    BAw[(size_t)row * 16 + 8 + dir * 4 + h] = cs;
  }
  if (item + (int)gridDim.x < 4352) ISSUE_T(item + (int)gridDim.x)
  LDS_SYNC();
  {
    const int fr = lane & 15, fq = lane >> 4;
    int tt = w >> 1;
#pragma unroll
    for (int u = 0; u < 2; ++u) {
      int st = (w & 1) * 2 + u;
      f32x4 a = f32x4{0.f, 0.f, 0.f, 0.f};
      if (st <= tt) {
#pragma unroll
        for (int k2 = 0; k2 < 4; ++k2)
          a = MFMA(ldfrag(ks, st * 16 + fr, 136, k2 * 32 + fq * 8), ldfrag(ks, tt * 16 + fr, 136, k2 * 32 + fq * 8), a);
      }
      int tau = tt * 16 + fr;
      float ct = cumL[tau], bt = betL[tau];
      f32x4 o;
#pragma unroll
      for (int r = 0; r < 4; ++r) {
        int sg = st * 16 + fq * 4 + r;
        o[r] = (sg < tau) ? bt * a[r] * __expf(ct - cumL[sg]) : 0.f;
      }
      *(f32x4*)(Am + tau * 68 + st * 16 + fq * 4) = o;
    }
  }
  LDS_SYNC();
  if (w < 4 && lane < 16) {
    const int I = w, cc = lane;
    float x[16];
#pragma unroll
    for (int i = 0; i < 16; ++i) {
      const f32x4* ap = (const f32x4*)(Am + (16 * I + i) * 68 + 16 * I);
      f32x4 a0 = ap[0], a1 = ap[1], a2 = ap[2], a3 = ap[3];
      const float aa[16] = {a0[0], a0[1], a0[2], a0[3], a1[0], a1[1], a1[2], a1[3], a2[0], a2[1], a2[2], a2[3], a3[0], a3[1], a3[2], a3[3]};
      float sacc = (i == cc) ? 1.f : 0.f;
#pragma unroll
      for (int ip = 0; ip < 16; ++ip)
        if (ip < i) sacc -= aa[ip] * x[ip];
      x[i] = sacc;
      Tm[(16 * I + i) * 68 + 16 * I + cc] = sacc;
    }
  }
  LDS_SYNC();
#pragma unroll 1
  for (int I = 1; I < 4; ++I) {
    for (int o = t; o < 256 * I; o += NT) {
      const int i = o & 15, cc = o >> 4;
      float sacc = 0.f;
      const float* arow = Am + (16 * I + i) * 68;
#pragma unroll 16
      for (int sg = 0; sg < 16 * I; ++sg) sacc += arow[sg] * Tm[sg * 68 + cc];
      Wm[i * 68 + cc] = sacc;
    }
    LDS_SYNC();
    for (int o = t; o < 256 * I; o += NT) {
      const int i = o & 15, cc = o >> 4;
      float sacc = 0.f;
      const float* trow = Tm + (16 * I + i) * 68 + 16 * I;
#pragma unroll
      for (int ip = 0; ip < 16; ++ip) sacc -= trow[ip] * Wm[ip * 68 + cc];
      Tm[(16 * I + i) * 68 + cc] = sacc;
    }
    LDS_SYNC();
  }
  {
    int tau = t >> 3, s0 = (t & 7) * 8;
    int row = chain_row(b, dir, c, tau);
    const float* tr = Tm + tau * 68 + s0;
    u32x4 o, ow;
#pragma unroll
    for (int i = 0; i < 4; ++i) {
      float x0 = tr[2 * i] * betL[s0 + 2 * i], x1 = tr[2 * i + 1] * betL[s0 + 2 * i + 1];
      o[i] = pack2(x0, x1);
      ow[i] = pack2(x0 * __expf(cumL[s0 + 2 * i]), x1 * __expf(cumL[s0 + 2 * i + 1]));
    }
    *(u32x4*)(PB + (size_t)row * 2304 + h * 128 + dir * 64 + s0) = o;
    *(u32x4*)((u16*)(lptr(p.ws) + OFF_NA) + (size_t)row * 1536 + 512 + h * 128 + dir * 64 + s0) = ow;
  }
  }
#undef ISSUE_T
}

__device__ __forceinline__ void chain_b(const P& p, int l, int item, char* smem) {
  const int t = TID(), lane = t & 63, w = t >> 6;
  const int vs = (item >> 3) & 3, chn = ((item >> 5) << 3) | (item & 7), dir = chn & 1, h = (chn >> 1) & 3, b = chn >> 3;
  u16* qs = (u16*)smem;
  u16* ks = qs + 64 * 136;
  u16* wl = ks + 64 * 136;
  u16* kT = wl + 64 * 136;
  u16* Tu = kT + 128 * 72;
  u16* Tw = Tu + 64 * 72;
  u16* at = Tw + 64 * 72;
  u16* vT = at + 64 * 72;
  u16* vnT = vT + 32 * 72;
  u16* vnsT = vnT + 32 * 72;
  u16* sT = vnsT + 32 * 72;
  float* cumL = (float*)(sT + 32 * 136);
  float* ecum = cumL + 64;
  float* elc = ecum + 64;
  float* misc = elc + 64;
  const u16* Q = (const u16*)(lptr(p.ws) + OFF_R + R_QKV);
  u16* PB = (u16*)(lptr(p.ws) + OFF_R + R_PB);
  const int fr = lane & 15, fq = lane >> 4;
  f32x4 S[2];
  S[0] = f32x4{0.f, 0.f, 0.f, 0.f};
  S[1] = S[0];
  u32x4 pq0, pq1, pk0, pk1, ptv, ptw;
  unsigned pv0, pv1;
  float pa = 0.f;
  const u16* NXp = (const u16*)(lptr(p.ws) + OFF_NA);
  const float* BAp = (const float*)(lptr(p.ws) + OFF_BA);
#define ISSUE_B(cc)                                                                               \
  {                                                                                               \
    int row = chain_row(b, dir, (cc), t & 63);                                                    \
    const u16* sq = Q + (size_t)row * 1536 + h * 128 + (t >> 6) * 16;                             \
    pq0 = *(const u32x4*)sq; pq1 = *(const u32x4*)(sq + 8);                                       \
    pk0 = *(const u32x4*)(sq + 512); pk1 = *(const u32x4*)(sq + 520);                             \
    const unsigned* vp = (const unsigned*)(Q + (size_t)row * 1536 + 1024 + h * 128 + vs * 32 + (t >> 6) * 4); \
    pv0 = vp[0]; pv1 = vp[1];                                                                     \
    int rowT = chain_row(b, dir, (cc), t >> 3);                                                   \
    ptv = *(const u32x4*)(PB + (size_t)rowT * 2304 + h * 128 + dir * 64 + (t & 7) * 8);           \
    ptw = *(const u32x4*)(NXp + (size_t)rowT * 1536 + 512 + h * 128 + dir * 64 + (t & 7) * 8);    \
    if (t < 64) {                                                                                 \
      int rowt = chain_row(b, dir, (cc), t);                                                      \
      pa = BAp[(size_t)rowt * 16 + 8 + dir * 4 + h];                                              \
    }                                                                                             \
  }
  ISSUE_B(0)
  for (int c = 0; c < 68; ++c) {
    LDS_SYNC();
    {
      int tauT = t >> 3, s0 = (t & 7) * 8;
      *(u32x4*)(Tu + tauT * 72 + s0) = ptv;
      *(u32x4*)(Tw + tauT * 72 + s0) = ptw;
    }
    {
      int tau = t & 63, d0 = (t >> 6) * 16;
      *(u32x4*)(qs + tau * 136 + d0) = pq0;
      *(u32x4*)(qs + tau * 136 + d0 + 8) = pq1;
      *(u32x4*)(ks + tau * 136 + d0) = pk0;
      *(u32x4*)(ks + tau * 136 + d0 + 8) = pk1;
#pragma unroll
      for (int i = 0; i < 4; ++i) {
        kT[(d0 + 2 * i) * 72 + tau] = (u16)(pk0[i] & 0xffff);
        kT[(d0 + 2 * i + 1) * 72 + tau] = (u16)(pk0[i] >> 16);
        kT[(d0 + 8 + 2 * i) * 72 + tau] = (u16)(pk1[i] & 0xffff);
        kT[(d0 + 8 + 2 * i + 1) * 72 + tau] = (u16)(pk1[i] >> 16);
      }
      int v4 = (t >> 6) * 4;
      vT[(v4 + 0) * 72 + tau] = (u16)(pv0 & 0xffff);
      vT[(v4 + 1) * 72 + tau] = (u16)(pv0 >> 16);
      vT[(v4 + 2) * 72 + tau] = (u16)(pv1 & 0xffff);
      vT[(v4 + 3) * 72 + tau] = (u16)(pv1 >> 16);
    }
    if (t < 64) {
      float cs = pa;
      float last = __shfl(cs, 63, 64);
      cumL[t] = cs;
      ecum[t] = __expf(cs);
      elc[t] = __expf(last - cs);
      if (t == 0) misc[0] = __expf(last);
    }
#pragma unroll
    for (int vt = 0; vt < 2; ++vt) *(uint2*)(sT + (vt * 16 + fr) * 136 + w * 16 + fq * 4) = pack4(S[vt]);
    if (c + 1 < 68) ISSUE_B(c + 1)
    LDS_SYNC();
    const int vt = w & 1, tt = w >> 1;
    f32x4 au = f32x4{0.f, 0.f, 0.f, 0.f};
    bf16x8 kfr[2], sfr[4];
    {
#pragma unroll
      for (int u = 0; u < 2; ++u) {
        int st = (w & 1) * 2 + u;
        f32x4 a = f32x4{0.f, 0.f, 0.f, 0.f};
        if (st <= tt) {
#pragma unroll
          for (int k2 = 0; k2 < 4; ++k2)
            a = MFMA(ldfrag(ks, st * 16 + fr, 136, k2 * 32 + fq * 8), ldfrag(qs, tt * 16 + fr, 136, k2 * 32 + fq * 8), a);
          int tau = tt * 16 + fr;
          float ct = cumL[tau];
#pragma unroll
          for (int r = 0; r < 4; ++r) {
            int sg = st * 16 + fq * 4 + r;
            a[r] = (sg <= tau) ? a[r] * __expf(ct - cumL[sg]) : 0.f;
          }
        }
        *(uint2*)(at + (tt * 16 + fr) * 72 + st * 16 + fq * 4) = pack4(a);
      }
#pragma unroll
      for (int k2 = 0; k2 < 2; ++k2)
        au = MFMA(ldfrag(vT, vt * 16 + fr, 72, k2 * 32 + fq * 8), ldfrag(Tu, tt * 16 + fr, 72, k2 * 32 + fq * 8), au);
      kfr[0] = ldfrag(kT, w * 16 + fr, 72, fq * 8);
      kfr[1] = ldfrag(kT, w * 16 + fr, 72, 32 + fq * 8);
#pragma unroll
      for (int t2 = 0; t2 < 4; ++t2) {
        f32x4 a = f32x4{0.f, 0.f, 0.f, 0.f};
#pragma unroll
        for (int k2 = 0; k2 < 2; ++k2)
          a = MFMA(kfr[k2], ldfrag(Tw, t2 * 16 + fr, 72, k2 * 32 + fq * 8), a);
        *(uint2*)(wl + (t2 * 16 + fr) * 136 + w * 16 + fq * 4) = pack4(a);
      }
    }
    LDS_SYNC();
    {
      f32x4 a = f32x4{0.f, 0.f, 0.f, 0.f};
#pragma unroll
      for (int k2 = 0; k2 < 4; ++k2) {
        sfr[k2] = ldfrag(sT, vt * 16 + fr, 136, k2 * 32 + fq * 8);
        a = MFMA(sfr[k2], ldfrag(wl, tt * 16 + fr, 136, k2 * 32 + fq * 8), a);
      }
      int tau = tt * 16 + fr;
      float el = elc[tau];
#pragma unroll
      for (int r = 0; r < 4; ++r) {
        float vn = au[r] - a[r];
        int vv = vt * 16 + fq * 4 + r;
        vnT[vv * 72 + tau] = f2bf(vn);
        vnsT[vv * 72 + tau] = f2bf(vn * el);
      }
    }
    LDS_SYNC();
    {
      f32x4 a1 = f32x4{0.f, 0.f, 0.f, 0.f}, a2 = f32x4{0.f, 0.f, 0.f, 0.f};
#pragma unroll
      for (int k2 = 0; k2 < 4; ++k2)
        a1 = MFMA(sfr[k2], ldfrag(qs, tt * 16 + fr, 136, k2 * 32 + fq * 8), a1);
#pragma unroll
      for (int k2 = 0; k2 < 2; ++k2)
        a2 = MFMA(ldfrag(vnT, vt * 16 + fr, 72, k2 * 32 + fq * 8), ldfrag(at, tt * 16 + fr, 72, k2 * 32 + fq * 8), a2);
      int tau = tt * 16 + fr;
      float ec = ecum[tau];
      f32x4 o;
#pragma unroll
      for (int r = 0; r < 4; ++r) o[r] = ec * a1[r] + a2[r];
      int row = chain_row(b, dir, c, tau);
      *(uint2*)(PB + (size_t)row * 2304 + 512 + dir * 512 + h * 128 + vs * 32 + vt * 16 + fq * 4) = pack4(o);
      float elast = misc[0];
#pragma unroll
      for (int v2 = 0; v2 < 2; ++v2) {
        f32x4 ds = f32x4{0.f, 0.f, 0.f, 0.f};
#pragma unroll
        for (int k2 = 0; k2 < 2; ++k2)
          ds = MFMA(kfr[k2], ldfrag(vnsT, v2 * 16 + fr, 72, k2 * 32 + fq * 8), ds);
#pragma unroll
        for (int r = 0; r < 4; ++r) S[v2][r] = elast * S[v2][r] + ds[r];
      }
    }
  }
}
#undef ISSUE_B

__device__ __forceinline__ void s5_tables(const P& p, int l, int item, char* smem) {
  const int t = TID();
  char* R = lptr(p.ws) + OFF_R;
  if (item < 512) {
    const int g = item >> 4, tb = item & 15;
    float2* pw = (float2*)smem;
    float2* Cc = pw + 512;
    __syncthreads();
    {
      int tl = t >> 7, dirx = (t >> 6) & 1, s0 = t & 63;
      int tau = tb * 4 + tl;
      S5c c = s5_load(p, l, dirx, g, s0);
      float pr, pi;
      s5_pow(c, dirx == 0 ? tau + 1 : 64 - tau, pr, pi);
      pw[t] = float2{pr, pi};
    }
    for (int e = t; e < 1024; e += NT) {
      int co = e >> 6, s2 = e & 63;
      Cc[e] = float2{lptr(p.in[19])[((size_t)(l * 32 + g) * 16 + co) * 64 + s2], lptr(p.in[20])[((size_t)(l * 32 + g) * 16 + co) * 64 + s2]};
    }
    __syncthreads();
    const float* KT = (const float*)(lptr(p.ws) + OFF_KT);
    u16* BP = (u16*)(R + R_BP);
    const int k = 2 * t, sg = k >> 4, ci = k & 15;
#pragma unroll 1
    for (int tl = 0; tl < 4; ++tl) {
      const int tau = tb * 4 + tl;
#pragma unroll 8
      for (int co = 0; co < 16; ++co) {
        float v0 = 0.f, v1 = 0.f;
        if (sg <= tau) { float2 a = *(const float2*)(KT + ((size_t)((0 * 32 + g) * 64 + (tau - sg))) * 256 + co * 16 + ci); v0 += a.x; v1 += a.y; }
        if (sg >= tau) { float2 a = *(const float2*)(KT + ((size_t)((1 * 32 + g) * 64 + (sg - tau))) * 256 + co * 16 + ci); v0 += a.x; v1 += a.y; }
        if (sg == tau) { float dsk = lptr(p.in[21])[l * 512 + g * 16 + co]; if (co == ci) v0 += dsk; if (co == ci + 1) v1 += dsk; }
        u16* rowp = BP + ((size_t)(g * 1024 + tau * 16 + co)) * 1280;
        *(unsigned*)(rowp + k) = pack2(v0, v1);
        if (t < 128) {
          int kk = 2 * t;
          int dirx = kk >> 7, si = kk & 127, s2 = si & 63, isim = si >> 6;
          float2 cA = Cc[co * 64 + s2], cB = Cc[co * 64 + s2 + 1];
          float2 pA = pw[(tl * 2 + dirx) * 64 + s2], pB = pw[(tl * 2 + dirx) * 64 + s2 + 1];
          float reA = cA.x * pA.x - cA.y * pA.y, imA = cA.x * pA.y + cA.y * pA.x;
          float reB = cB.x * pB.x - cB.y * pB.y, imB = cB.x * pB.y + cB.y * pB.x;
          *(unsigned*)(rowp + 1024 + kk) = isim ? pack2(-imA, -imB) : pack2(reA, reB);
        }
      }
    }
  } else {
    item -= 512;
    const int sb = item & 7, g = (item >> 3) & 31, dir = item >> 8;
    float2* pc = (float2*)smem;
    __syncthreads();
    {
      int sl = t >> 6, s0 = t & 63;
      int sg = sb * 8 + sl;
      S5c c = s5_load(p, l, dir, g, s0);
      float pr, pi, cr, ci;
      s5_pow(c, dir == 0 ? 63 - sg : sg, pr, pi);
      s5_coef(c, cr, ci);
      pc[t] = float2{pr * cr - pi * ci, pr * ci + pi * cr};
    }
    __syncthreads();
    u16* M1 = (u16*)(R + R_M1);
    const float* bre = lptr(p.in[17]) + (size_t)(l * 32 + g) * 1024;
    const float* bim = lptr(p.in[18]) + (size_t)(l * 32 + g) * 1024;
#pragma unroll 8
    for (int e = t; e < 16384; e += NT) {
      int n = e >> 7, kk = e & 127, sl = kk >> 4, ci2 = kk & 15;
      int s0 = n & 63, isim = n >> 6;
      float br = bre[s0 * 16 + ci2], bi = bim[s0 * 16 + ci2];
      float2 q = pc[sl * 64 + s0];
      float v = isim ? (q.x * bi + q.y * br) : (q.x * br - q.y * bi);
      M1[((size_t)((dir * 32 + g) * 128 + n)) * 1024 + sb * 128 + kk] = f2bf(v);
    }
  }
}

__device__ __forceinline__ void s5_state(const P& p, int tile, char* smem) {
  char* R = lptr(p.ws) + OFF_R;
  const int dg = tile / 3, tm = tile % 3;
  const int g = dg & 31;
  f32x4 acc[4][4];
  zero_acc(acc);
  gemm_loop((const u16*)(R + R_UG) + ((size_t)(g * 768 + tm * 256)) * 1280, 1280,
            (const u16*)(R + R_M1) + (size_t)dg * 128 * 1024, 1024, 1024, smem, acc);
  float* DS = (float*)(R + R_DS);
  EPI_LOOP({
    int chunk = tm * 256 + ml;
    if (chunk < 544) *(float4*)(DS + ((size_t)(dg * 768 + chunk)) * 128 + nl) = float4{v[0], v[1], v[2], v[3]};
  })
}

__device__ __forceinline__ void s5_scan(const P& p, int l, int item) {
  const int id = item * NT + TID();
  const int s = id & 63, g = (id >> 6) & 31, dir = (id >> 11) & 1, b = id >> 12;
  char* R = lptr(p.ws) + OFF_R;
  S5c c = s5_load(p, l, dir, g, s);
  float a_r, a_i;
  s5_pow(c, 64, a_r, a_i);
  const float* DS = (const float*)(R + R_DS);
  u16* UG = (u16*)(R + R_UG);
  float xr = 0.f, xi = 0.f;
#pragma unroll 1
  for (int bt = 0; bt < 4; ++bt) {
    float dr[17], di[17];
#pragma unroll
    for (int i = 0; i < 17; ++i) {
      int step = bt * 17 + i;
      int c68 = dir == 0 ? step : (step < 4 ? 3 - step : 71 - step);
      const float* dp = DS + ((size_t)((dir * 32 + g) * 768 + b * 68 + c68)) * 128;
      dr[i] = dp[s];
      di[i] = dp[64 + s];
    }
#pragma unroll
    for (int i = 0; i < 17; ++i) {
      int step = bt * 17 + i;
      int c68 = dir == 0 ? step : (step < 4 ? 3 - step : 71 - step);
      u16* up = UG + ((size_t)(g * 768 + b * 68 + c68)) * 1280 + 1024 + dir * 128;
      up[s] = f2bf(xr);
      up[64 + s] = f2bf(xi);
      float nr = a_r * xr - a_i * xi + dr[i];
      float ni = a_r * xi + a_i * xr + di[i];
      xr = nr;
      xi = ni;
    }
  }
}

__device__ __forceinline__ void final_norm(const P& p, int item) {
  const int t = TID(), lane = t & 63, w = t >> 6;
  const int r = item * 8 + w;
  float* xr = lptr(p.out) + (size_t)r * 1024;
  float4 v[4];
  float ss = 0.f;
#pragma unroll
  for (int i = 0; i < 4; ++i) {
    v[i] = *(const float4*)(xr + i * 256 + lane * 4);
    ss += v[i].x * v[i].x + v[i].y * v[i].y + v[i].z * v[i].z + v[i].w * v[i].w;
  }
  ss = wsum(ss);
  float rstd = rsqrtf(ss * (1.f / 1024.f) + 1e-6f);
#pragma unroll
  for (int i = 0; i < 4; ++i) {
    int c = i * 256 + lane * 4;
    float4 wv = *(const float4*)(lptr(p.in[30]) + c);
    float4 o{v[i].x * rstd * wv.x, v[i].y * rstd * wv.y, v[i].z * rstd * wv.z, v[i].w * rstd * wv.w};
    *(float4*)(xr + c) = o;
  }
}

struct OrderStatic {
  int nM, nN, nwg, G, c;
  __device__ void init(int M, int N, int G_, int c_) { nM = M / 256; nN = N / 256; nwg = nM * nN; G = G_; c = c_; }
  __device__ bool next(int i, pg8::Unit& u) const {
    const long L = (long)i * G + c;
    if (L >= nwg) return false;
    int wgid = (int)L;
    { const int q = nwg / 8, r = nwg % 8, xcd = wgid % 8, off = wgid / 8; wgid = (xcd < r ? xcd * (q + 1) : r * (q + 1) + (xcd - r) * q) + off; }
    const int nig = 8 * nN, gid = wgid / nig, fm = gid * 8, gsz = (nM - fm) < 8 ? (nM - fm) : 8;
    u.pm = fm + ((wgid % nig) % gsz);
    u.pn = (wgid % nig) / gsz;
    return true;
  }
  __device__ __forceinline__ void a_ready(const pg8::Unit&) const {}
  __device__ __forceinline__ void done(const pg8::Unit&) const {}
};
struct OrderS5 {
  int G, c;
  __device__ bool next(int i, pg8::Unit& u) const {
    int L = i * G + c;
    if (L >= 384) return false;
    int g = L / 12, rem = L % 12;
    u.pm = g * 3 + (rem >> 2);
    u.pn = g * 4 + (rem & 3);
    return true;
  }
  __device__ __forceinline__ void a_ready(const pg8::Unit&) const {}
  __device__ __forceinline__ void done(const pg8::Unit&) const {}
};

#define PG_EPI_LOOP(...)                                                                   \
  _Pragma("unroll") for (int ai = 0; ai < 2; ++ai)                                         \
  _Pragma("unroll") for (int m = 0; m < 4; ++m)                                            \
  _Pragma("unroll") for (int bj = 0; bj < 2; ++bj)                                         \
  _Pragma("unroll") for (int n = 0; n < 2; ++n) {                                          \
    const int row = u.pm * 256 + ai * 128 + wr * 64 + m * 16 + fr;                         \
    const int col = u.pn * 256 + bj * 128 + wc * 32 + n * 16 + 4 * fq;                     \
    f32x4 v = acc[ai][bj][m][n];                                                           \
    __VA_ARGS__                                                                            \
  }
#define PG_EPI_LOOP8(...)                                                                  \
  _Pragma("unroll") for (int ai = 0; ai < 2; ++ai)                                         \
  _Pragma("unroll") for (int m = 0; m < 4; ++m)                                            \
  _Pragma("unroll") for (int bj = 0; bj < 2; ++bj) {                                       \
    const int row = u.pm * 256 + ai * 128 + wr * 64 + m * 16 + fr;                         \
    const int col = u.pn * 256 + bj * 128 + wc * 32 + 8 * fq;                              \
    f32x4 v0 = acc[ai][bj][m][0], v1 = acc[ai][bj][m][1];                                  \
    __VA_ARGS__                                                                            \
  }
__device__ __forceinline__ u32x4 pack8(f32x4 a, f32x4 b) { uint2 p0 = pack4(a), p1 = pack4(b); u32x4 r; r[0] = p0.x; r[1] = p0.y; r[2] = p1.x; r[3] = p1.y; return r; }
__device__ __forceinline__ void unpack8(u32x4 g, f32x4& a, f32x4& b) {
  a[0] = bf2f((u16)(g[0] & 0xffff)); a[1] = bf2f((u16)(g[0] >> 16)); a[2] = bf2f((u16)(g[1] & 0xffff)); a[3] = bf2f((u16)(g[1] >> 16));
  b[0] = bf2f((u16)(g[2] & 0xffff)); b[1] = bf2f((u16)(g[2] >> 16)); b[2] = bf2f((u16)(g[3] & 0xffff)); b[3] = bf2f((u16)(g[3] >> 16));
}
#define PG_EPI_SIG const f32x4 (&acc)[2][2][4][2], const pg8::Unit& u, int wr, int wc, int fr, int fq

template <int MODE> struct EpiStore {
  static constexpr bool PERM = true, AFTER_DRAIN = false, RESCALE = false;
  u16* C; int ldc; float* BA;
  __device__ __forceinline__ void operator()(PG_EPI_SIG) const {
    _Pragma("unroll") for (int ai = 0; ai < 2; ++ai)
    _Pragma("unroll") for (int m = 0; m < 4; ++m)
    _Pragma("unroll") for (int bj = 0; bj < 2; ++bj) {
      const int row = u.pm * 256 + ai * 128 + wr * 64 + m * 16 + fr;
      const int col = u.pn * 256 + bj * 128 + wc * 32 + 8 * fq;
      f32x4 v0 = acc[ai][bj][m][0], v1 = acc[ai][bj][m][1];
      f32x4 o0 = v0, o1 = v1;
      if (MODE == 3) { _Pragma("unroll") for (int r = 0; r < 4; ++r) { o0[r] = sigm(v0[r]); o1[r] = sigm(v1[r]); } }
      if (MODE == 4) { _Pragma("unroll") for (int r = 0; r < 4; ++r) { float x = fmaxf(v0[r], 0.f); o0[r] = x * x; float y = fmaxf(v1[r], 0.f); o1[r] = y * y; } }
      uint2 p0 = pack4(o0), p1 = pack4(o1);
      u32x4 pk; pk[0] = p0.x; pk[1] = p0.y; pk[2] = p1.x; pk[3] = p1.y;
      *(u32x4*)(C + (size_t)row * ldc + col) = pk;
      if (MODE == 1) {
        if (col >= 2048 && col < 2064) {
          float* bp = BA + (size_t)row * 16 + (col - 2048);
          *(f32x4*)bp = v0;
          *(f32x4*)(bp + 4) = v1;
        }
      }
    }
  }
};
struct EpiUg {
  static constexpr bool PERM = true, AFTER_DRAIN = false, RESCALE = false;
  u16* UG;
  __device__ __forceinline__ void operator()(PG_EPI_SIG) const {
    PG_EPI_LOOP8({
      int chunk, tau;
      if (row < MLAT) { int b = row >> 12, tt = row & 4095; chunk = b * 68 + 4 + (tt & 63); tau = tt >> 6; }
      else { int mm = row - MLAT; int b = mm >> 8, jj = mm & 255; chunk = b * 68 + (jj >> 6); tau = jj & 63; }
      int g = col >> 4, ci = col & 15;
      *(u32x4*)(UG + ((size_t)(g * 768 + chunk)) * 1280 + tau * 16 + ci) = pack8(v0, v1);
    })
  }
};
struct EpiGlu {
  static constexpr bool PERM = true, AFTER_DRAIN = false, RESCALE = false;
  const u16* ZC; u16* GL;
  __device__ __forceinline__ void operator()(PG_EPI_SIG) const {
    const int rowb = u.pm * 256 + wr * 64 + fr;
    const int colb = u.pn * 256 + wc * 32 + 8 * fq;
    _Pragma("unroll") for (int ai = 0; ai < 2; ++ai) {
      u32x4 z[4][2];
      _Pragma("unroll") for (int m = 0; m < 4; ++m)
      _Pragma("unroll") for (int bj = 0; bj < 2; ++bj)
        z[m][bj] = *(const u32x4*)(ZC + (size_t)(rowb + ai * 128 + m * 16) * 512 + colb + bj * 128);
      _Pragma("unroll") for (int m = 0; m < 4; ++m)
      _Pragma("unroll") for (int bj = 0; bj < 2; ++bj) {
        f32x4 z0, z1;
        unpack8(z[m][bj], z0, z1);
        f32x4 v0 = acc[ai][bj][m][0], v1 = acc[ai][bj][m][1];
        _Pragma("unroll") for (int r = 0; r < 4; ++r) { z0[r] *= sigm(v0[r]); z1[r] *= sigm(v1[r]); }
        *(u32x4*)(GL + (size_t)(rowb + ai * 128 + m * 16) * 1536 + colb + bj * 128) = pack8(z0, z1);
      }
    }
  }
};
struct EpiMix {
  static constexpr bool PERM = true, AFTER_DRAIN = false, RESCALE = true;
  const u16* PG; u16* MIX;
  __device__ __forceinline__ void rescale(f32x4 (&acc)[2][2][4][2], const pg8::Unit& u, int wr, int wc, int fr, int fq, int nb) const {
    int frl = fr;
    asm volatile("" : "+v"(frl));
    const unsigned base = (unsigned)((u.pm * 256 + wr * 64 + frl) * 3072 + u.pn * 256 + wc * 32 + 8 * fq + (nb - 1) * 1024);
    const u16* pgb = lptr(PG);
    _Pragma("unroll") for (int ai = 0; ai < 2; ++ai) {
      u32x4 ga[4][2], gb[4][2];
      _Pragma("unroll") for (int m = 0; m < 4; ++m)
      _Pragma("unroll") for (int bj = 0; bj < 2; ++bj) {
        const unsigned off = base + (unsigned)((ai * 128 + m * 16) * 3072 + bj * 128);
        ga[m][bj] = *(const u32x4*)(pgb + off);
        gb[m][bj] = *(const u32x4*)(pgb + off + 1024);
      }
      _Pragma("unroll") for (int m = 0; m < 4; ++m)
      _Pragma("unroll") for (int bj = 0; bj < 2; ++bj) {
        f32x4 a0, a1, b0, b1;
        unpack8(ga[m][bj], a0, a1);
        unpack8(gb[m][bj], b0, b1);
        f32x4 v0 = acc[ai][bj][m][0], v1 = acc[ai][bj][m][1];
        _Pragma("unroll") for (int r = 0; r < 4; ++r) {
          v0[r] *= a0[r] * __builtin_amdgcn_rcpf(fmaxf(b0[r], 1e-20f));
          v1[r] *= a1[r] * __builtin_amdgcn_rcpf(fmaxf(b1[r], 1e-20f));
        }
        acc[ai][bj][m][0] = v0;
        acc[ai][bj][m][1] = v1;
      }
      __builtin_amdgcn_sched_barrier(0);
    }
  }
  __device__ __forceinline__ void operator()(PG_EPI_SIG) const {
    const int rowb = u.pm * 256 + wr * 64 + fr;
    const int colb = u.pn * 256 + wc * 32 + 8 * fq;
    _Pragma("unroll") for (int ai = 0; ai < 2; ++ai) {
      u32x4 gq[4][2];
      _Pragma("unroll") for (int m = 0; m < 4; ++m)
      _Pragma("unroll") for (int bj = 0; bj < 2; ++bj)
        gq[m][bj] = *(const u32x4*)(PG + (size_t)(rowb + ai * 128 + m * 16) * 3072 + 2048 + colb + bj * 128);
      _Pragma("unroll") for (int m = 0; m < 4; ++m)
      _Pragma("unroll") for (int bj = 0; bj < 2; ++bj) {
        f32x4 g0, g1;
        unpack8(gq[m][bj], g0, g1);
        f32x4 v0 = acc[ai][bj][m][0], v1 = acc[ai][bj][m][1];
        _Pragma("unroll") for (int r = 0; r < 4; ++r) { g0[r] *= v0[r]; g1[r] *= v1[r]; }
        *(u32x4*)(MIX + (size_t)(rowb + ai * 128 + m * 16) * 1024 + colb + bj * 128) = pack8(g0, g1);
      }
    }
  }
};
struct EpiRes {
  static constexpr bool PERM = true, AFTER_DRAIN = false, RESCALE = false;
  const float* xin; float* out; float* xc; const float* modsb;
  __device__ __forceinline__ void operator()(PG_EPI_SIG) const {
    const int rowb = u.pm * 256 + wr * 64 + fr;
    const int colb = u.pn * 256 + wc * 32 + 8 * fq;
    const bool lat = rowb < MLAT;
    const float* srcb = lat ? xin + (size_t)rowb * 1024 + colb : xc + (size_t)(rowb - MLAT) * 1024 + colb;
    float* dstb = lat ? out + (size_t)rowb * 1024 + colb : xc + (size_t)(rowb - MLAT) * 1024 + colb;
    const float* gp = modsb + (size_t)mod_idx(rowb) * 6144 + colb;
    f32x4 g[2][2];
    _Pragma("unroll") for (int bj = 0; bj < 2; ++bj) { g[bj][0] = *(const f32x4*)(gp + bj * 128); g[bj][1] = *(const f32x4*)(gp + bj * 128 + 4); }
    _Pragma("unroll") for (int ai = 0; ai < 2; ++ai) {
      f32x4 x[4][2][2];
      _Pragma("unroll") for (int m = 0; m < 4; ++m)
      _Pragma("unroll") for (int bj = 0; bj < 2; ++bj) {
        const float* sp = srcb + (size_t)(ai * 128 + m * 16) * 1024 + bj * 128;
        x[m][bj][0] = *(const f32x4*)sp;
        x[m][bj][1] = *(const f32x4*)(sp + 4);
      }
      _Pragma("unroll") for (int m = 0; m < 4; ++m)
      _Pragma("unroll") for (int bj = 0; bj < 2; ++bj) {
        float* dp = dstb + (size_t)(ai * 128 + m * 16) * 1024 + bj * 128;
        *(f32x4*)dp = x[m][bj][0] + g[bj][0] * acc[ai][bj][m][0];
        *(f32x4*)(dp + 4) = x[m][bj][1] + g[bj][1] * acc[ai][bj][m][1];
      }
    }
  }
};
struct EpiS5Out {
  static constexpr bool PERM = true, AFTER_DRAIN = false, RESCALE = false;
  u16* ZC;
  __device__ __forceinline__ void operator()(PG_EPI_SIG) const {
    const int g = u.pm / 3;
    PG_EPI_LOOP8({
      int chunk = row - g * 768;
      if (chunk < 544) {
        int nn = col - g * 1024;
        int tau = nn >> 4, co = nn & 15;
        int b = chunk / 68, c68 = chunk % 68;
        int orow = c68 < 4 ? MLAT + b * 256 + c68 * 64 + tau : b * 4096 + tau * 64 + (c68 - 4);
        f32x4 z0, z1;
        _Pragma("unroll") for (int r = 0; r < 4; ++r) { z0[r] = geluf(v0[r]); z1[r] = geluf(v1[r]); }
        *(u32x4*)(ZC + (size_t)orow * 512 + g * 16 + co) = pack8(z0, z1);
      }
    })
  }
};

template <class Epi>
__device__ __forceinline__ void run_gemm(const u16* A, const u16* Bt, int M, int N, int K, const Epi& E, char* smem) {
  OrderStatic S;
  S.init(M, N, gridDim.x, blockIdx.x);
  pg8::Gemm g{A, Bt, M, N, K};
  __syncthreads();
  pg8::gemm_phase<Epi, OrderStatic, false>((PG8_LAS unsigned char*)smem, g, S, E, nullptr);
  __syncthreads();
}

__device__ __forceinline__ void gemm_simple(const P& p, int mode, char* smem, int M = MALL) {
  const u16* H = (const u16*)(lptr(p.ws) + OFF_H);
  const u16* WT = (const u16*)(lptr(p.ws) + OFF_WT);
  char* R = lptr(p.ws) + OFF_R;
  if (mode == 0) {
    EpiStore<0> E{(u16*)(R + R_PA), 2560, nullptr};
    run_gemm(H, WT + W_IN, MALL, 2560, 1024, E, smem);
  } else if (mode == 1) {
    EpiStore<1> E{(u16*)(R + R_PB), 2304, (float*)(lptr(p.ws) + OFF_BA)};
    run_gemm(H, WT + W_IN + (size_t)2560 * 1024, MALL, 2304, 1024, E, smem);
  } else if (mode == 2) {
    EpiUg E{(u16*)(R + R_UG)};
    run_gemm(H, WT + W_IN + (size_t)4864 * 1024, MALL, 512, 1024, E, smem);
  } else if (mode == 3) {
    EpiStore<3> E{(u16*)(R + R_PG), 3072, nullptr};
    run_gemm(H, WT + W_IN + (size_t)5376 * 1024, M, 3072, 1024, E, smem);
  } else {
    EpiStore<4> E{(u16*)(R + R_HID), 4096, nullptr};
    run_gemm(H, WT + W_FF1, M, 4096, 1024, E, smem);
  }
}
__device__ __forceinline__ void s5_out(const P& p, char* smem) {
  char* R = lptr(p.ws) + OFF_R;
  OrderS5 S{(int)gridDim.x, (int)blockIdx.x};
  pg8::Gemm g{(const u16*)(R + R_UG), (const u16*)(R + R_BP), 32 * 768, 32 * 1024, 1280};
  EpiS5Out E{(u16*)(R + R_ZC)};
  __syncthreads();
  pg8::gemm_phase<EpiS5Out, OrderS5, false>((PG8_LAS unsigned char*)smem, g, S, E, nullptr);
  __syncthreads();
}
__device__ __forceinline__ void glu_gemm(const P& p, char* smem, int M) {
  char* R = lptr(p.ws) + OFF_R;
  EpiGlu E{(const u16*)(R + R_ZC), (u16*)(lptr(p.ws) + OFF_NA) + 1024};
  run_gemm((const u16*)(R + R_ZC), (const u16*)(lptr(p.ws) + OFF_WT) + W_GLU, M, 512, 512, E, smem);
}
__device__ __forceinline__ void mix_gemm(const P& p, char* smem, int M) {
  const u16* WT = (const u16*)(lptr(p.ws) + OFF_WT);
  EpiMix E{(const u16*)(lptr(p.ws) + OFF_R + R_PG), (u16*)(lptr(p.ws) + OFF_H)};
  run_gemm((const u16*)(lptr(p.ws) + OFF_NA), WT + W_BA, M, 1024, 1536, E, smem);
}
__device__ __forceinline__ void res_gemm(const P& p, int l, int which, char* smem, int M) {
  const u16* WT = (const u16*)(lptr(p.ws) + OFF_WT);
  EpiRes E;
  E.xin = (which == 0 && l == 0) ? lptr(p.in[0]) : lptr(p.out);
  E.out = lptr(p.out);
  E.xc = (float*)(lptr(p.ws) + OFF_XC);
  E.modsb = (const float*)(lptr(p.ws) + OFF_MODS) + (size_t)l * 9 * 6144 + (which == 0 ? 2 : 5) * 1024;
  if (which == 0) run_gemm((const u16*)(lptr(p.ws) + OFF_H), WT + W_O, M, 1024, 1024, E, smem);
  else run_gemm((const u16*)(lptr(p.ws) + OFF_R + R_HID), WT + W_FF2, M, 1024, 4096, E, smem);
}

#define XB_TMO      128
#define XB_XCNT(j)  (256  + 64 * (j))
#define XB_XSUB(j)  (1280 + 64 * (j))
#define XB_XGEN(j)  (2304 + 64 * (j))
#define XB_TOP      3328
#define XB_TOPGEN   3392
#define XCD_BAR_WORDS 3456
#define XB_SPIN_CAP (1u << 21)
#define LAS __attribute__((address_space(3)))

__device__ __forceinline__ unsigned xb_ld(unsigned* p)              { return __hip_atomic_load(p, __ATOMIC_RELAXED, __HIP_MEMORY_SCOPE_AGENT); }
__device__ __forceinline__ unsigned xb_add(unsigned* p, unsigned v) { return __hip_atomic_fetch_add(p, v, __ATOMIC_RELAXED, __HIP_MEMORY_SCOPE_AGENT); }
__device__ __forceinline__ unsigned xb_xcc_id() { return (unsigned)__builtin_amdgcn_s_getreg((3 << 11) | 20) & 0xFu; }
#define XB_SPIN(cond, bar) do { unsigned _sp = 0; while (cond) { __builtin_amdgcn_s_sleep(1); \
    if ((++_sp & 255u) == 0u) { if (xb_ld(&(bar)[XB_TMO])) break; if (_sp > XB_SPIN_CAP) { atomicAdd(&(bar)[XB_TMO], 1u); break; } } } } while (0)

struct XcdBarrier {
    unsigned* bar; unsigned x;
    volatile LAS unsigned* st;
};

__device__ __forceinline__ XcdBarrier xcd_barrier_post(unsigned* bar, volatile LAS unsigned* st) {
    XcdBarrier b; b.bar = bar; b.x = xb_xcc_id(); b.st = st;
    if (TID() == 0) (void)xb_add(&bar[XB_XCNT(b.x)], 1u);
    return b;
}
__device__ __forceinline__ void xcd_barrier_complete(unsigned* bar, unsigned x, unsigned& nloc, unsigned& nx) {
    const unsigned G = gridDim.x * gridDim.y * gridDim.z;
    unsigned sum, cnt, mine, sp = 0u;
    for (;;) {
        sum = 0u; cnt = 0u; mine = 0u;
#pragma unroll
        for (unsigned j = 0; j < 16; ++j) { const unsigned c = xb_ld(&bar[XB_XCNT(j)]); sum += c; cnt += (c > 0u) ? 1u : 0u; mine = (j == x) ? c : mine; }
        if (sum == G) break;
        __builtin_amdgcn_s_sleep(1);
        if ((++sp & 255u) == 0u) { if (xb_ld(&bar[XB_TMO])) break; if (sp > XB_SPIN_CAP) { atomicAdd(&bar[XB_TMO], 1u); break; } }
    }
    nloc = mine > 0u ? mine : 1u; nx = cnt > 0u ? cnt : 1u;
}

__device__ __forceinline__ void xcd_barrier(const XcdBarrier& b) {
    asm volatile("s_waitcnt vmcnt(0)" ::: "memory");
    __syncthreads();
    if (TID() == 0) {
        unsigned* bar = b.bar;
        __builtin_amdgcn_s_waitcnt(0);
        unsigned nloc = b.st[0], nx = b.st[1];
        if (nloc == 0u) { xcd_barrier_complete(bar, b.x, nloc, nx); b.st[0] = nloc; b.st[1] = nx; }
        const unsigned old = xb_add(&bar[XB_XSUB(b.x)], 1u);
        const unsigned gen = old / nloc;
        if (old + 1u == (gen + 1u) * nloc) {
            __builtin_amdgcn_fence(__ATOMIC_RELEASE, "agent");
            asm volatile("s_waitcnt vmcnt(0)" ::: "memory");
            const unsigned og = xb_add(&bar[XB_TOP], 1u);
            const unsigned tg = og / nx;
            if (og + 1u == (tg + 1u) * nx) xb_add(&bar[XB_TOPGEN], 1u);
            else XB_SPIN(xb_ld(&bar[XB_TOPGEN]) == tg, bar);
            __builtin_amdgcn_fence(__ATOMIC_ACQUIRE, "agent");
            xb_add(&bar[XB_XGEN(b.x)], 1u);
            asm volatile("s_waitcnt vmcnt(0)" ::: "memory");
        } else {
            XB_SPIN(xb_ld(&bar[XB_XGEN(b.x)]) == gen, bar);
            __builtin_amdgcn_fence(__ATOMIC_ACQUIRE, "agent");
            asm volatile("s_waitcnt vmcnt(0)" ::: "memory");
        }
    }
    __syncthreads();
}


#define NSUB 20
#ifndef PROBE_MASK
#define PROBE_MASK 0
#endif
#define NPHASE (1 + 2 * NSUB + 1)

__device__ __forceinline__ void run_phase(const P& p, int ph, char* smem) {
  const int bid = blockIdx.x, nb = gridDim.x;
  if (ph == 0) {
    for (int i = bid; i < 449 + 1216 + 512; i += nb) {
      if (i < 449) ph_init(p, i, smem);
      else if (i < 449 + 1216) ph_start(p, 0, i - 449, smem);
      else ph_start(p, 0, 3392 + (i - 449 - 1216), smem);
    }
    return;
  }
  if (ph == NPHASE - 1) { for (int i = bid; i < 4096; i += nb) final_norm(p, i); return; }
  const int l = (ph - 1) / NSUB, sub = (ph - 1) % NSUB;
  const int Mr = (l == 1) ? MLAT : MALL;
  switch (sub) {
    case 0:
      if (l == 0) { for (int i = 1216 + bid; i < 1216 + 2176; i += nb) ph_start(p, l, i, smem); }
      else { for (int i = bid; i < 1216 + 2176 + 512; i += nb) ph_start(p, l, i, smem); }
      break;
    case 1: gemm_simple(p, 0, smem); break;
    case 2: prep_a(p, l, smem); break;
    case 3: for (int i = bid; i < 256; i += nb) chain_a(p, l, i, smem); break;
    case 4: for (int i = bid; i < 2176; i += nb) normgate(p, l, i, 0); break;
    case 5: gemm_simple(p, 1, smem); break;
    case 6: for (int i = bid; i < 3264; i += nb) conv_b(p, l, i); break;
    case 7: tphase_b(p, l, smem); break;
    case 8: for (int i = bid; i < 256; i += nb) chain_b(p, l, i, smem); break;
    case 9: for (int i = bid; i < 2176; i += nb) normgate(p, l, i, 1); break;
    case 10:
      gemm_simple(p, 2, smem);
      for (int i = bid; i < 1024; i += nb) s5_tables(p, l, i, smem);
      break;
    case 11: for (int i = bid; i < 192; i += nb) s5_state(p, i, smem); break;
    case 12: for (int i = bid; i < 64; i += nb) s5_scan(p, l, i); break;
    case 13: s5_out(p, smem); break;
    case 14:
      glu_gemm(p, smem, Mr);
      gemm_simple(p, 3, smem, Mr);
      break;
    case 15: mix_gemm(p, smem, Mr); break;
    case 16: res_gemm(p, l, 0, smem, Mr); break;
    case 17: for (int i = bid; i < Mr / 16; i += nb) norm_rows(p, l, i, 1); break;
    case 18: gemm_simple(p, 4, smem, Mr); break;
    case 19: res_gemm(p, l, 1, smem, Mr); break;
  }
}

__global__ void __launch_bounds__(NT) mega(P p, int ph_lo, int ph_hi) {
  extern __shared__ __attribute__((aligned(16))) char smem[];
  cg::grid_group grid = cg::this_grid();
  unsigned* stw = (unsigned*)(smem + 131072);
  if (threadIdx.x == 0) { stw[0] = 0u; stw[1] = 0u; stw[2] = 0u; stw[3] = 0u; }
  __syncthreads();
  XcdBarrier xb;
  if (ph_hi - ph_lo > 1) xb = xcd_barrier_post((unsigned*)(p.ws + OFF_BAR), (volatile LAS unsigned*)stw);
  for (int ph = ph_lo; ph < ph_hi; ++ph) {
    run_phase(p, ph, smem);
    if (PROBE_MASK != 0 && ph > 0 && ph < NPHASE - 1 && ((PROBE_MASK >> ((ph - 1) % NSUB)) & 1)) { __syncthreads(); run_phase(p, ph, smem); }
    if (ph + 1 < ph_hi) { if (ph == ph_lo) grid.sync(); else xcd_barrier(xb); }
  }
}

extern "C" void kernel_launch(void* const* d_in, const int* in_sizes, int n_in, void* d_out, int out_size, void* d_ws,
                              size_t ws_size, hipStream_t stream) {
  static int grid_blocks = 0;
  if (!grid_blocks) {
    hipFuncSetAttribute((const void*)mega, hipFuncAttributeMaxDynamicSharedMemorySize, LDS_BYTES);
    int dev = 0, cus = 0, per_cu = 0;
    hipGetDevice(&dev);
    hipDeviceGetAttribute(&cus, hipDeviceAttributeMultiprocessorCount, dev);
    hipOccupancyMaxActiveBlocksPerMultiprocessor(&per_cu, mega, NT, LDS_BYTES);
    if (per_cu < 1) per_cu = 1;
    grid_blocks = cus * per_cu;
  }
  P p{};
  for (int i = 0; i < 31; ++i) p.in[i] = (const float*)d_in[i];
  p.out = (float*)d_out;
  p.ws = (char*)d_ws;
#if COOP
  hipMemsetAsync((char*)d_ws + OFF_BAR, 0, XCD_BAR_WORDS * 4, stream);
  int lo = 0, hi = NPHASE;
  void* args[] = {&p, &lo, &hi};
  hipError_t e = hipLaunchCooperativeKernel((void*)mega, dim3(grid_blocks), dim3(NT), args, LDS_BYTES, stream);
  if (e != hipSuccess) fprintf(stderr, "cooperative launch failed: %s (grid %d)\n", hipGetErrorString(e), grid_blocks);
#else
  for (int ph = 0; ph < NPHASE; ++ph) mega<<<grid_blocks, NT, LDS_BYTES, stream>>>(p, ph, ph + 1);
#endif
}
```

```cpp
#include <hip/hip_runtime.h>
#include <hip/hip_cooperative_groups.h>
#include <cstdio>
namespace cg = cooperative_groups;

typedef unsigned short u16;
typedef __attribute__((ext_vector_type(8))) short bf16x8;
typedef __attribute__((ext_vector_type(4))) float f32x4;
typedef __attribute__((ext_vector_type(4))) unsigned int u32x4;

#ifndef COOP
#define COOP 1
#endif

#define NT 512
#define MLAT 32768
#define MALL 34816
#define LDS_BYTES (131072 + 64)

constexpr size_t SZ_WT   = 19922944ull * 2;
constexpr size_t OFF_WT  = 0;
constexpr size_t OFF_H   = OFF_WT + SZ_WT;
constexpr size_t SZ_H    = 34816ull * 1024 * 2;
constexpr size_t SZ_N    = 34816ull * 512 * 2;
constexpr size_t OFF_NA  = OFF_H + SZ_H;
constexpr size_t OFF_NB  = OFF_NA + SZ_N;
constexpr size_t OFF_GL  = OFF_NB + SZ_N;
constexpr size_t OFF_XC  = OFF_GL + SZ_N;
constexpr size_t OFF_MODS = OFF_XC + 2048ull * 1024 * 4;
constexpr size_t OFF_LB  = OFF_MODS + 442368;
constexpr size_t OFF_KT  = OFF_LB + 8192;
constexpr size_t OFF_BA  = OFF_KT + 4194304;
constexpr size_t OFF_R   = OFF_BA + 34816ull * 16 * 4;
constexpr size_t OFF_BAR = OFF_R + 34816ull * 4096 * 2;
constexpr size_t R_PA = 0;
constexpr size_t R_OF = 34816ull * 2560 * 2;
constexpr size_t R_OB = R_OF + SZ_N;
constexpr size_t R_PB = 0;
constexpr size_t R_QKV = 34816ull * 2304 * 2;
constexpr size_t R_UG = 0;
constexpr size_t R_BP = 32ull * 768 * 1280 * 2;
constexpr size_t R_M1 = R_BP + 32ull * 1024 * 1280 * 2;
constexpr size_t R_DS = R_M1 + 64ull * 128 * 1024 * 2;
constexpr size_t R_ZC = 240000000ull;
constexpr size_t R_PG = 0;
constexpr size_t R_HID = 0;
constexpr size_t W_IN = 0, W_FF1 = 8650752, W_FF2 = 12845056, W_O = 17039360, W_BA = 18087936,
                 W_BB = 18612224, W_BC = 19136512, W_GLU = 19660800;

struct P {
  const float* in[31];
  float* out;
  char* ws;
};

__device__ __forceinline__ int TID() { int t = threadIdx.x; asm volatile("" : "+v"(t)); return t; }
template <class T> __device__ __forceinline__ T* lptr(T* q) {
  unsigned long long v = (unsigned long long)q;
  unsigned lo = __builtin_amdgcn_readfirstlane((unsigned)v), hi = __builtin_amdgcn_readfirstlane((unsigned)(v >> 32));
  asm volatile("" : "+s"(lo), "+s"(hi));
  typedef __attribute__((address_space(1))) T GT;
  GT* g = (GT*)(((unsigned long long)hi << 32) | lo);
  return (T*)g;
}

__device__ __forceinline__ u16 f2bf(float f) {
  unsigned u = __float_as_uint(f);
  u += 0x7fffu + ((u >> 16) & 1u);
  return (u16)(u >> 16);
}
__device__ __forceinline__ float bf2f(u16 h) { return __uint_as_float(((unsigned)h) << 16); }
typedef float f2v_t __attribute__((ext_vector_type(2)));
typedef __bf16 bf2v_t __attribute__((ext_vector_type(2)));
__device__ __forceinline__ unsigned pack2(float a, float b) {
  f2v_t v = {a, b};
  bf2v_t r = __builtin_convertvector(v, bf2v_t);
  return __builtin_bit_cast(unsigned, r);
}
__device__ __forceinline__ uint2 pack4(f32x4 v) { uint2 r; r.x = pack2(v[0], v[1]); r.y = pack2(v[2], v[3]); return r; }
__device__ __forceinline__ float dpp_f(float v, const int ctrl_sel) {
  int x = __builtin_bit_cast(int, v), r;
  if (ctrl_sel == 0) r = __builtin_amdgcn_update_dpp(x, x, 0xB1, 0xF, 0xF, false);
  else if (ctrl_sel == 1) r = __builtin_amdgcn_update_dpp(x, x, 0x4E, 0xF, 0xF, false);
  else if (ctrl_sel == 2) r = __builtin_amdgcn_update_dpp(x, x, 0x141, 0xF, 0xF, false);
  else r = __builtin_amdgcn_update_dpp(x, x, 0x140, 0xF, 0xF, false);
  return __builtin_bit_cast(float, r);
}
__device__ __forceinline__ float wsum(float v) {
  v += dpp_f(v, 0);
  v += dpp_f(v, 1);
  v += dpp_f(v, 2);
  v += dpp_f(v, 3);
  v += __shfl_xor(v, 16, 64);
  v += __shfl_xor(v, 32, 64);
  return v;
}
__device__ __forceinline__ float sigm(float x) { return __builtin_amdgcn_rcpf(1.f + __expf(-x)); }
__device__ __forceinline__ float siluf(float x) { return x * __builtin_amdgcn_rcpf(1.f + __expf(-x)); }
__device__ __forceinline__ float geluf(float x) {
  float u = 1.5957691216057308f * (x + 0.044715f * x * x * x);
  return x * __builtin_amdgcn_rcpf(1.f + __expf(-u));
}
__device__ __forceinline__ bf16x8 ldfrag(const u16* base, int row, int stride, int koff) {
  return *(const bf16x8*)(base + row * stride + koff);
}
#define LDS_SYNC() do { asm volatile("s_waitcnt lgkmcnt(0)" ::: "memory"); __builtin_amdgcn_s_barrier(); asm volatile("" ::: "memory"); } while (0)
#define MFMA(a, b, c) __builtin_amdgcn_mfma_f32_16x16x32_bf16(a, b, c, 0, 0, 0)

__device__ __forceinline__ int chain_row(int b, int dir, int c, int tau) {
  if (dir == 0) {
    if (c < 4) return MLAT + b * 256 + c * 64 + tau;
    return b * 4096 + (c - 4) * 64 + tau;
  } else {
    if (c < 4) return MLAT + b * 256 + (3 - c) * 64 + 63 - tau;
    return b * 4096 + (67 - c) * 64 + 63 - tau;
  }
}

namespace pg8 {
#define PG8_LAS __attribute__((address_space(3)))
typedef unsigned short bf16_t;
typedef short bf16x8 __attribute__((ext_vector_type(8)));
typedef float f32x4 __attribute__((ext_vector_type(4)));
typedef unsigned u32x4 __attribute__((ext_vector_type(4)));
constexpr int BM = 256, BK = 64, HALF = 128, HTB = HALF * BK * 2  , STAGE_BYTES = 8 * HTB, NXCD = 8, WGM = 8;

__host__ __device__ __forceinline__ int lds_byte(int r, int c) { const int st = (r >> 4) * 2 + (c >> 5), rr = r & 15, cc = c & 31, ob = rr * 64 + cc * 2; return st * 1024 + (ob ^ (((ob >> 9) & 1) << 5)); }
__host__ __device__ __forceinline__ void stage_rc(int b, int& R, int& C) { const int st = b / 1024, sb = b % 1024, swz = sb ^ (((sb >> 9) & 1) << 5); R = (st >> 1) * 16 + swz / 64; C = (st & 1) * 32 + (swz % 64) / 2; }
__host__ __device__ __forceinline__ int perm32(int rho) { const int n = rho >> 4, i = rho & 15; return 8 * (i >> 2) + 4 * n + (i & 3); }

struct Unit { int pm, pn; };
struct Gemm { const bf16_t* A; const bf16_t* Bt; int M, N, K; };

template <class Epi, class Sched, bool STAMP = false>
__device__ __forceinline__ void gemm_phase(PG8_LAS unsigned char* lds, const Gemm g, const Sched& S, const Epi& E, unsigned long long* stamps) {
    const int tid = TID(), wid = __builtin_amdgcn_readfirstlane(tid >> 6), lane = tid & 63, wr = wid >> 2, wc = wid & 3, fr = lane & 15, fq = lane >> 4;
    const int K = g.K, nt = K / BK;
    int ts_lo = 0, ts_hi = 0, nts = 0; const unsigned long long rt_entry = STAMP ? (unsigned long long)wall_clock64() : 0ull;
#define PG8_STAMP() do { if (STAMP && wid == 0 && nts < 64) { const unsigned long long _c = (unsigned long long)clock64(); \
        ts_lo = (lane == nts) ? (int)(unsigned)_c : ts_lo; ts_hi = (lane == nts) ? (int)(unsigned)(_c >> 32) : ts_hi; ++nts; } } while (0)
    PG8_STAMP();
    unsigned voffA[2], voffB[2];
#pragma unroll
    for (int i = 0; i < 2; ++i) { int R, C; stage_rc(tid * 16 + i * 8192, R, C); const int Rb = Epi::PERM ? ((R & ~31) + perm32(R & 31)) : R;
        voffA[i] = (unsigned)(R * K + C) * 2u; voffB[i] = (unsigned)(Rb * K + C) * 2u; }
    const size_t kstep = (size_t)(BK * 2);
    const size_t hstep = (size_t)HALF * K * 2;
    const size_t tstep = 2 * hstep;
    const unsigned ldsw = (unsigned)wid * 1024u;
    const int aoff = lds_byte(wr * 64 + fr, fq * 8), boff = lds_byte(wc * 32 + fr, fq * 8);
#define PG8_SA(b, h) (((b) * 2 + (h)) * HTB)
#define PG8_SB(b, h) ((4 + (b) * 2 + (h)) * HTB)
#define PG8_STAGE(bufoff, gbase, voff) do { _Pragma("unroll") for (int _i = 0; _i < 2; ++_i) \
        __builtin_amdgcn_global_load_lds((const unsigned*)((const char*)(gbase) + (voff)[_i]), (PG8_LAS unsigned*)(lds + (bufoff) + ldsw + _i * 8192), 16, 0, 0); } while (0)
#define PG8_LDA(dst, b, h) do { _Pragma("unroll") for (int m = 0; m < 4; ++m) _Pragma("unroll") for (int k = 0; k < 2; ++k) dst[m][k] = *(const PG8_LAS bf16x8*)(lds + PG8_SA(b, h) + aoff + m * 2048 + k * 1024); } while (0)
#define PG8_LDB(dst, b, h) do { _Pragma("unroll") for (int n = 0; n < 2; ++n) _Pragma("unroll") for (int k = 0; k < 2; ++k) dst[n][k] = *(const PG8_LAS bf16x8*)(lds + PG8_SB(b, h) + boff + n * 2048 + k * 1024); } while (0)
#define PG8_MMA(ai, bj, At, Bt) do { __builtin_amdgcn_s_setprio(1); _Pragma("unroll") for (int m = 0; m < 4; ++m) _Pragma("unroll") for (int n = 0; n < 2; ++n) _Pragma("unroll") for (int k = 0; k < 2; ++k) \
        acc[ai][bj][m][n] = __builtin_amdgcn_mfma_f32_16x16x32_bf16(Bt[n][k], At[m][k], acc[ai][bj][m][n], 0, 0, 0); __builtin_amdgcn_s_setprio(0); } while (0)
#define PG8_WAIT_V(n) asm volatile("s_waitcnt vmcnt(" #n ")" ::: "memory")
#define PG8_WAIT_L(n) asm volatile("s_waitcnt lgkmcnt(" #n ")" ::: "memory")
#define PG8_BAR __builtin_amdgcn_s_barrier()
#define PG8_SCHED __builtin_amdgcn_sched_barrier(0)
    Unit cur, nxt; int ui = 0;
    if (!S.next(0, cur)) return;
    f32x4 acc[2][2][4][2];
#pragma unroll
    for (int a = 0; a < 2; ++a)
#pragma unroll
        for (int b = 0; b < 2; ++b)
#pragma unroll
            for (int m = 0; m < 4; ++m)
#pragma unroll
                for (int n = 0; n < 2; ++n) acc[a][b][m][n] = (f32x4){0.f, 0.f, 0.f, 0.f};
    bf16x8 At[4][2], B0[2][2], B1[2][2];
    const char* cA = (const char*)g.A + (size_t)cur.pm * tstep; const char* cB = (const char*)g.Bt + (size_t)cur.pn * tstep;
    S.a_ready(cur);
    PG8_STAGE(PG8_SB(0, 0), cB, voffB); PG8_STAGE(PG8_SA(0, 0), cA, voffA); PG8_STAGE(PG8_SB(0, 1), cB + hstep, voffB); PG8_STAGE(PG8_SA(0, 1), cA + hstep, voffA);
    if (wr == 1) PG8_BAR;
    PG8_WAIT_V(4); PG8_BAR;
    PG8_STAGE(PG8_SB(1, 0), cB + kstep, voffB); PG8_STAGE(PG8_SA(1, 0), cA + kstep, voffA); PG8_STAGE(PG8_SB(1, 1), cB + hstep + kstep, voffB);
    PG8_WAIT_V(6); PG8_BAR;
    PG8_STAMP();
    for (;;) {
        const bool has_next = S.next(ui + 1, nxt);
        const char* nA = has_next ? (const char*)g.A + (size_t)nxt.pm * tstep : cA; const char* nB = has_next ? (const char*)g.Bt + (size_t)nxt.pn * tstep : cB;
        for (int t = 0; t < nt; t += 2) {
            const bool last = (t == nt - 2);
            const char* a1 = cA + (size_t)(t + 1) * kstep;
            const char* a2 = last ? nA : cA + (size_t)(t + 2) * kstep; const char* b2 = last ? nB : cB + (size_t)(t + 2) * kstep;
            const char* a3 = a2 + kstep; const char* b3 = b2 + kstep;
            if constexpr (Epi::RESCALE) { if (t == 8 || t == 16) E.rescale(acc, cur, wr, wc, fr, fq, t >> 3); }
            if (last && has_next) S.a_ready(nxt);
            PG8_LDB(B0, 0, 0); PG8_SCHED; PG8_LDA(At, 0, 0); PG8_STAGE(PG8_SA(1, 1), a1 + hstep, voffA);
            PG8_WAIT_L(8); PG8_BAR; PG8_WAIT_L(0); PG8_MMA(0, 0, At, B0); PG8_BAR; PG8_SCHED;
            PG8_LDB(B1, 0, 1); PG8_STAGE(PG8_SB(0, 0), b2, voffB);
            PG8_BAR; PG8_WAIT_L(0); PG8_MMA(0, 1, At, B1); PG8_BAR;
            PG8_LDA(At, 0, 1); PG8_STAGE(PG8_SA(0, 0), a2, voffA);
            PG8_BAR; PG8_WAIT_L(0); PG8_MMA(1, 0, At, B0); PG8_BAR; PG8_SCHED;
            PG8_STAGE(PG8_SB(0, 1), b2 + hstep, voffB);
            PG8_WAIT_V(6); PG8_BAR; PG8_MMA(1, 1, At, B1); PG8_BAR;
            PG8_LDB(B0, 1, 0); PG8_SCHED; PG8_LDA(At, 1, 0); PG8_STAGE(PG8_SA(0, 1), a2 + hstep, voffA);
            PG8_WAIT_L(8); PG8_BAR; PG8_WAIT_L(0); PG8_MMA(0, 0, At, B0); PG8_BAR; PG8_SCHED;
            PG8_LDB(B1, 1, 1); PG8_STAGE(PG8_SB(1, 0), b3, voffB);
            PG8_BAR; PG8_WAIT_L(0); PG8_MMA(0, 1, At, B1); PG8_BAR;
            PG8_LDA(At, 1, 1); PG8_STAGE(PG8_SA(1, 0), a3, voffA);
            PG8_BAR; PG8_WAIT_L(0); PG8_MMA(1, 0, At, B0); PG8_BAR; PG8_SCHED;
            PG8_STAGE(PG8_SB(1, 1), b3 + hstep, voffB);
            PG8_WAIT_V(6); PG8_BAR; PG8_MMA(1, 1, At, B1); PG8_BAR;
        }
        PG8_STAMP();
        if constexpr (!Epi::AFTER_DRAIN) { E(acc, cur, wr, wc, fr, fq); S.done(cur); }
        PG8_STAMP();
        if (!has_next) break;
#pragma unroll
        for (int a = 0; a < 2; ++a)
#pragma unroll
            for (int b = 0; b < 2; ++b)
#pragma unroll
                for (int m = 0; m < 4; ++m)
#pragma unroll
                    for (int n = 0; n < 2; ++n) acc[a][b][m][n] = (f32x4){0.f, 0.f, 0.f, 0.f};
        cur = nxt; cA = nA; cB = nB; ++ui;
    }
    PG8_WAIT_V(0);
    if (wr == 0) PG8_BAR;
    PG8_BAR;
    if constexpr (Epi::AFTER_DRAIN) { E.fused(acc, cur, wr, wc, fr, fq, lds, wid, lane); S.done(cur); }
    PG8_STAMP();
    if (STAMP && wid == 0) { stamps[lane] = lane < nts ? (((unsigned long long)(unsigned)ts_hi << 32) | (unsigned)ts_lo) : 0ull;
        if (lane == 62) stamps[62] = rt_entry; if (lane == 63) stamps[63] = (unsigned long long)wall_clock64(); }
#undef PG8_STAMP
#undef PG8_SA
#undef PG8_SB
#undef PG8_STAGE
#undef PG8_LDA
#undef PG8_LDB
#undef PG8_MMA
#undef PG8_WAIT_V
#undef PG8_WAIT_L
#undef PG8_BAR
#undef PG8_SCHED
}
}


__device__ __forceinline__ void gemm_loop(const u16* __restrict__ A, long lda, const u16* __restrict__ W, long ldw,
                                          int K, char* smem, f32x4 (&acc)[4][4]) {
  const int t = TID(), lane = t & 63, w = t >> 6, wm = w & 3, wn = w >> 2;
  const int lr = t >> 3, kc = (t & 7) * 8;
  u16* sA = (u16*)smem;
  u16* sW = sA + 256 * 72;
  const u16* ga = A + (long)lr * lda + kc;
  const u16* gw = W + (long)lr * ldw + kc;
  u32x4 ra[4], rw[2];
#pragma unroll
  for (int i = 0; i < 4; ++i) ra[i] = *(const u32x4*)(ga + (long)(64 * i) * lda);
#pragma unroll
  for (int i = 0; i < 2; ++i) rw[i] = *(const u32x4*)(gw + (long)(64 * i) * ldw);
  const int fr = lane & 15, fq = (lane >> 4) * 8;
  for (int k0 = 0; k0 < K; k0 += 64) {
    __syncthreads();
#pragma unroll
    for (int i = 0; i < 4; ++i) *(u32x4*)(sA + (lr + 64 * i) * 72 + kc) = ra[i];
#pragma unroll
    for (int i = 0; i < 2; ++i) *(u32x4*)(sW + (lr + 64 * i) * 72 + kc) = rw[i];
    __syncthreads();
    if (k0 + 64 < K) {
#pragma unroll
      for (int i = 0; i < 4; ++i) ra[i] = *(const u32x4*)(ga + (long)(64 * i) * lda + k0 + 64);
#pragma unroll
      for (int i = 0; i < 2; ++i) rw[i] = *(const u32x4*)(gw + (long)(64 * i) * ldw + k0 + 64);
    }
#pragma unroll
    for (int ks = 0; ks < 2; ++ks) {
      bf16x8 fa[4], fw[4];
#pragma unroll
      for (int i = 0; i < 4; ++i) fw[i] = ldfrag(sW, wn * 64 + i * 16 + fr, 72, ks * 32 + fq);
#pragma unroll
      for (int j = 0; j < 4; ++j) fa[j] = ldfrag(sA, wm * 64 + j * 16 + fr, 72, ks * 32 + fq);
#pragma unroll
      for (int i = 0; i < 4; ++i)
#pragma unroll
        for (int j = 0; j < 4; ++j) acc[i][j] = MFMA(fw[i], fa[j], acc[i][j]);
    }
  }
}
__device__ __forceinline__ void zero_acc(f32x4 (&acc)[4][4]) {
#pragma unroll
  for (int i = 0; i < 4; ++i)
#pragma unroll
    for (int j = 0; j < 4; ++j) acc[i][j] = f32x4{0.f, 0.f, 0.f, 0.f};
}
#define EPI_LOOP(...)                                                         \
  {                                                                           \
    const int _t = TID(), _lane = _t & 63, _w = _t >> 6;                \
    const int _wm = _w & 3, _wn = _w >> 2;                                    \
    _Pragma("unroll") for (int _i = 0; _i < 4; ++_i)                          \
    _Pragma("unroll") for (int _j = 0; _j < 4; ++_j) {                        \
      const int ml = _wm * 64 + _j * 16 + (_lane & 15);                       \
      const int nl = _wn * 64 + _i * 16 + (_lane >> 4) * 4;                   \
      f32x4 v = acc[_i][_j];                                                  \
      __VA_ARGS__                                                             \
    }                                                                         \
  }

__device__ __forceinline__ int mod_idx(int r) { return r < MLAT ? (r >> 12) : 8; }

struct S5c { float lr, li, dt; };
__device__ __forceinline__ S5c s5_load(const P& p, int l, int dir, int g, int s) {
  S5c c;
  float lre = lptr(p.in[14])[((l * 2 + dir) * 32 + g) * 64 + s];
  c.lr = fminf(lre, -1e-4f);
  c.li = lptr(p.in[15])[((l * 2 + dir) * 32 + g) * 64 + s];
  c.dt = expf(lptr(p.in[16])[(l * 2 + dir) * 32 + g]);
  return c;
}
__device__ __forceinline__ void s5_pow(const S5c& c, int j, float& re, float& im) {
  float mag = expf(c.lr * c.dt * (float)j);
  float th = c.li * c.dt;
  th -= 6.283185307179586f * rintf(th * 0.15915494309189535f);
  float ang = th * (float)j;
  float sn, cs;
  sincosf(ang, &sn, &cs);
  re = mag * cs;
  im = mag * sn;
}
__device__ __forceinline__ void s5_coef(const S5c& c, float& cr, float& ci) {
  float ar, ai;
  s5_pow(c, 1, ar, ai);
  float den = c.lr * c.lr + c.li * c.li;
  cr = ((ar - 1.0f) * c.lr + ai * c.li) / den;
  ci = (ai * c.lr - (ar - 1.0f) * c.li) / den;
}


__device__ __forceinline__ void ph_init(const P& p, int item, char* smem) {
  const int t = TID();
  if (item < 192) {
    const int l = item / 96, nb = item % 96;
    float* sc = (float*)smem;
    float* part = sc + 9 * 1024;
    __syncthreads();
    for (int e = t; e < 9 * 1024; e += NT) {
      int r = e >> 10, k = e & 1023;
      float cv = r < 8 ? lptr(p.in[1])[r * 1024 + k] : lptr(p.in[3])[k];
      sc[e] = siluf(cv);
    }
    __syncthreads();
    const int col = t & 63, kg = t >> 6;
    const float* wp = lptr(p.in[4]) + (size_t)l * 1024 * 6144 + nb * 64 + col;
    float a[9];
#pragma unroll
    for (int r = 0; r < 9; ++r) a[r] = 0.f;
    for (int k = kg * 128; k < kg * 128 + 128; ++k) {
      float wv = wp[(size_t)k * 6144];
#pragma unroll
      for (int r = 0; r < 9; ++r) a[r] += sc[r * 1024 + k] * wv;
    }
#pragma unroll
    for (int r = 0; r < 9; ++r) part[(kg * 9 + r) * 64 + col] = a[r];
    __syncthreads();
    float* mods = (float*)(lptr(p.ws) + OFF_MODS);
    for (int e = t; e < 9 * 64; e += NT) {
      int r = e >> 6, c2 = e & 63;
      float s = 0.f;
      for (int g2 = 0; g2 < 8; ++g2) s += part[(g2 * 9 + r) * 64 + c2];
      int n = nb * 64 + c2;
      mods[(l * 9 + r) * 6144 + n] = s + lptr(p.in[5])[l * 6144 + n];
    }
  } else if (item < 448) {
    const int it = item - 192;
    const float4* src = (const float4*)lptr(p.in[2]);
    float4* dst = (float4*)(lptr(p.ws) + OFF_XC);
#pragma unroll
    for (int i = 0; i < 4; ++i) dst[(size_t)it * 2048 + i * 512 + t] = src[(size_t)it * 2048 + i * 512 + t];
  } else {
    float* lb = (float*)(lptr(p.ws) + OFF_LB);
    for (int e = t; e < 1024; e += NT) {
      float l0 = lptr(p.in[8])[e], l1 = lptr(p.in[8])[1024 + e];
      float m = fmaxf(l0, l1);
      float e0 = expf(l0 - m), e1 = expf(l1 - m);
      lb[e] = 0.f;
      lb[1024 + e] = e1 / (e0 + e1);
    }
  }
}

__device__ __forceinline__ void transpose_tile(const float* __restrict__ src, int Nsrc, u16* __restrict__ dst, int K, int tn, int tk4,
                               bool win_map, char* smem, int ldd = 0, int koff = 0) {
  if (ldd == 0) ldd = K;
  float* tile = (float*)smem;
  const int t = TID(), tx = t & 63, ty = t >> 6;
  __syncthreads();
  int np = tn * 64 + tx;
  int sc = np;
  bool zero = false;
  if (win_map) {
    if (np >= 4864) sc = np - 240;
    else if (np >= 4624) zero = true;
  }
  float v[32];
#pragma unroll
  for (int i = 0; i < 32; ++i) {
    int kk = ty + 8 * i;
    v[i] = zero ? 0.f : src[(size_t)(tk4 * 256 + kk) * Nsrc + sc];
  }
#pragma unroll
  for (int i = 0; i < 32; ++i) tile[tx * 257 + ty + 8 * i] = v[i];
  __syncthreads();
#pragma unroll
  for (int i = 0; i < 8; ++i) {
    int nn = ty + 8 * i;
#pragma unroll
    for (int j = 0; j < 2; ++j) {
      int kk = 2 * tx + 128 * j;
      *(unsigned*)(dst + (size_t)(tn * 64 + nn) * ldd + koff + tk4 * 256 + kk) = pack2(tile[nn * 257 + kk], tile[nn * 257 + kk + 1]);
    }
  }
}

__device__ __forceinline__ void norm_rows(const P& p, int l, int item, int which) {
  const int t = TID(), lane = t & 63, w = t >> 6;
  const float* nw = (which == 0 ? lptr(p.in[6]) : lptr(p.in[27])) + l * 1024;
  float4 v[2][4];
  float ss[2];
#pragma unroll
  for (int q = 0; q < 2; ++q) {
    const int r = item * 16 + w * 2 + q;
    const float* xr;
    if (r < MLAT) xr = ((which == 0 && l == 0) ? lptr(p.in[0]) : lptr(p.out)) + (size_t)r * 1024;
    else xr = (const float*)(lptr(p.ws) + OFF_XC) + (size_t)(r - MLAT) * 1024;
#pragma unroll
    for (int i = 0; i < 4; ++i) v[q][i] = *(const float4*)(xr + i * 256 + lane * 4);
  }
#pragma unroll
  for (int q = 0; q < 2; ++q) {
    float a = 0.f;
#pragma unroll
    for (int i = 0; i < 4; ++i) a += v[q][i].x * v[q][i].x + v[q][i].y * v[q][i].y + v[q][i].z * v[q][i].z + v[q][i].w * v[q][i].w;
    ss[q] = wsum(a);
  }
#pragma unroll
  for (int q = 0; q < 2; ++q) {
    const int r = item * 16 + w * 2 + q;
    const float* mods = (const float*)(lptr(p.ws) + OFF_MODS) + (size_t)(l * 9 + mod_idx(r)) * 6144;
    const float* sh = mods + (which == 0 ? 0 : 3) * 1024;
    const float* scl = mods + (which == 0 ? 1 : 4) * 1024;
    float rstd = rsqrtf(ss[q] * (1.f / 1024.f) + 1e-6f);
    u16* H = (u16*)(lptr(p.ws) + OFF_H) + (size_t)r * 1024;
#pragma unroll
    for (int i = 0; i < 4; ++i) {
      int c = i * 256 + lane * 4;
      float4 wv = *(const float4*)(nw + c), s1 = *(const float4*)(sh + c), s2 = *(const float4*)(scl + c);
      f32x4 o;
      o[0] = v[q][i].x * rstd * wv.x * (1.f + s2.x) + s1.x;
      o[1] = v[q][i].y * rstd * wv.y * (1.f + s2.y) + s1.y;
      o[2] = v[q][i].z * rstd * wv.z * (1.f + s2.z) + s1.z;
      o[3] = v[q][i].w * rstd * wv.w * (1.f + s2.w) + s1.w;
      *(uint2*)(H + c) = pack4(o);
    }
  }
}

__device__ __forceinline__ void s5_ktable(const P& p, int l, int item, char* smem) {
  const int t = TID();
  const int jb = item & 7, g = (item >> 3) & 31, dir = item >> 8;
  float2* pwB = (float2*)smem;
  float2* Cc = pwB + 8192;
  float2* pc = Cc + 1024;
  __syncthreads();
  {
    int s0 = t & 63, jj = t >> 6;
    S5c c = s5_load(p, l, dir, g, s0);
    float pr, pi, cr, ci;
    s5_pow(c, jb * 8 + jj, pr, pi);
    s5_coef(c, cr, ci);
    pc[t] = float2{pr * cr - pi * ci, pr * ci + pi * cr};
  }
#pragma unroll 1
  for (int e = t; e < 1024; e += NT) {
    int co = e >> 6, s2 = e & 63;
    Cc[e] = float2{lptr(p.in[19])[((size_t)(l * 32 + g) * 16 + co) * 64 + s2], lptr(p.in[20])[((size_t)(l * 32 + g) * 16 + co) * 64 + s2]};
  }
  __syncthreads();
#pragma unroll 1
  for (int e = t; e < 1024; e += NT) {
    int s = e >> 4;
    float br = lptr(p.in[17])[((size_t)(l * 32 + g) * 64) * 16 + e];
    float bi = lptr(p.in[18])[((size_t)(l * 32 + g) * 64) * 16 + e];
#pragma unroll
    for (int jj = 0; jj < 8; ++jj) {
      float2 q = pc[jj * 64 + s];
      pwB[jj * 1024 + e] = float2{q.x * br - q.y * bi, q.x * bi + q.y * br};
    }
  }
  __syncthreads();
  float* KT = (float*)(lptr(p.ws) + OFF_KT);
#pragma unroll 1
  for (int o = t; o < 2048; o += NT) {
    int jj = o >> 8, cc = o & 255, co = cc >> 4, ci2 = cc & 15;
    float acc = 0.f;
#pragma unroll 8
    for (int s = 0; s < 64; ++s) {
      float2 c = Cc[co * 64 + s], b = pwB[jj * 1024 + s * 16 + ci2];
      acc += c.x * b.x - c.y * b.y;
    }
    KT[((size_t)((dir * 32 + g) * 64 + jb * 8 + jj)) * 256 + cc] = acc;
  }
}

__device__ __forceinline__ void ph_start(const P& p, int l, int item, char* smem) {
  u16* WT = (u16*)(lptr(p.ws) + OFF_WT);
  if (item < 1216) {
    int it = item;
    if (it < 528) { transpose_tile(lptr(p.in[7]) + (size_t)l * 1024 * 8208, 8208, WT + W_IN, 1024, it >> 2, it & 3, true, smem); return; }
    it -= 528;
    if (it < 256) { transpose_tile(lptr(p.in[28]) + (size_t)l * 1024 * 4096, 4096, WT + W_FF1, 1024, it >> 2, it & 3, false, smem); return; }
    it -= 256;
    if (it < 256) { transpose_tile(lptr(p.in[29]) + (size_t)l * 4096 * 1024, 1024, WT + W_FF2, 4096, it >> 4, it & 15, false, smem); return; }
    it -= 256;
    if (it < 64) { transpose_tile(lptr(p.in[26]) + (size_t)l * 1024 * 1024, 1024, WT + W_O, 1024, it >> 2, it & 3, false, smem); return; }
    it -= 64;
    if (it < 96) {
      int which = it >> 5, ii = it & 31;
      const float* src = lptr(p.in[23 + which]) + (size_t)l * 512 * 1024;
      transpose_tile(src, 1024, WT + W_BA, 512, ii >> 1, ii & 1, false, smem, 1536, which * 512);
      return;
    }
    it -= 96;
    transpose_tile(lptr(p.in[22]) + (size_t)l * 512 * 512, 512, WT + W_GLU, 512, it >> 1, it & 1, false, smem);
    return;
  }
  item -= 1216;
  if (item < 2176) { norm_rows(p, l, item, 0); return; }
  item -= 2176;
  s5_ktable(p, l, item, smem);
}

__device__ __forceinline__ void prep_a(const P& p, int l, char* smem) {
  const int t = TID(), lane = t & 63, w = t >> 6;
  u16* qh = (u16*)smem;
  u16* kh = qh + 64 * 136;
  u16* ktl = kh + 64 * 136;
  u16* vT = ktl + 128 * 72;
  u16* at = vT + 128 * 72;
  float* tot = (float*)(at + 64 * 72);
  float* c31 = tot + 512;
  float* lst = c31 + 128;
  u16* PA = (u16*)(lptr(p.ws) + OFF_R + R_PA);
  u16* NX = (u16*)(lptr(p.ws) + OFF_NA);
  float* EL = (float*)(lptr(p.ws) + OFF_BA);
  const int d = t & 127, qtr = t >> 7;
  const int fr = lane & 15, fq = lane >> 4;
  u16 zr[16], qr[16];
  u32x4 pv0, pv1;
#define ISSUE_P(jj)                                                                             \
  {                                                                                             \
    const int it_ = (int)blockIdx.x + ((jj) >> 1) * (int)gridDim.x, dir_ = (jj) & 1;            \
    const int cn_ = it_ % 68, h_ = (it_ / 68) & 3, b_ = it_ / 272;                              \
    const int cs_ = dir_ == 0 ? cn_ : (cn_ < 4 ? 3 - cn_ : 71 - cn_);                           \
    _Pragma("unroll") for (int i = 0; i < 16; ++i) {                                            \
      int row_ = chain_row(b_, dir_, cs_, qtr * 16 + i);                                        \
      const u16* pr_ = PA + (size_t)row_ * 2560;                                                \
      zr[i] = pr_[1024 + dir_ * 512 + h_ * 128 + d];                                            \
      qr[i] = pr_[h_ * 128 + d];                                                                \
    }                                                                                           \
    int rowv_ = chain_row(b_, dir_, cs_, t >> 3);                                               \
    const u32x4* vp_ = (const u32x4*)(PA + (size_t)rowv_ * 2560 + 512 + h_ * 128 + (t & 7) * 16); \
    pv0 = vp_[0]; pv1 = vp_[1];                                                                 \
  }
  const int nj = ((2176 - (int)blockIdx.x + (int)gridDim.x - 1) / (int)gridDim.x) * 2;
  if (nj > 0) ISSUE_P(0)
#pragma unroll 1
  for (int j = 0; j < nj; ++j) {
    const int item = (int)blockIdx.x + (j >> 1) * (int)gridDim.x, dir = j & 1;
    const int cnat = item % 68, h = (item / 68) & 3, b = item / 272;
    const int rbase = cnat < 4 ? MLAT + b * 256 + cnat * 64 : b * 4096 + (cnat - 4) * 64;
    const int cstep = dir == 0 ? cnat : (cnat < 4 ? 3 - cnat : 71 - cnat);
    const float lbv = ((const float*)(lptr(p.ws) + OFF_LB))[(l * 2 + dir) * 512 + h * 128 + d];
    u16* OUT = (u16*)(lptr(p.ws) + OFF_R + (dir == 0 ? R_OF : R_OB));
    float cum[16], qv[16], kv[16];
    LDS_SYNC();
    {
      float run = 0.f;
#pragma unroll
      for (int i = 0; i < 16; ++i) {
        float z = bf2f(zr[i]);
        float f = lbv + (1.f - lbv) * sigm(z);
        run += __logf(f);
        cum[i] = run;
        kv[i] = 1.f - f;
        qv[i] = siluf(bf2f(qr[i]));
      }
      tot[qtr * 128 + d] = run;
    }
    {
      int sg = t >> 3, v0 = (t & 7) * 16;
      u32x4 a0 = pv0, a1 = pv1;
#pragma unroll
      for (int i = 0; i < 4; ++i) {
        vT[(v0 + 2 * i) * 72 + sg] = (u16)(a0[i] & 0xffff);
        vT[(v0 + 2 * i + 1) * 72 + sg] = (u16)(a0[i] >> 16);
        vT[(v0 + 8 + 2 * i) * 72 + sg] = (u16)(a1[i] & 0xffff);
        vT[(v0 + 8 + 2 * i + 1) * 72 + sg] = (u16)(a1[i] >> 16);
      }
    }
    if (j + 1 < nj) ISSUE_P(j + 1)
    LDS_SYNC();
    {
      float off = 0.f;
      for (int q2 = 0; q2 < qtr; ++q2) off += tot[q2 * 128 + d];
#pragma unroll
      for (int i = 0; i < 16; ++i) cum[i] += off;
      if (qtr == 1) c31[d] = cum[15];
      if (qtr == 3) lst[d] = cum[15];
    }
    LDS_SYNC();
    {
      float cm = c31[d], la = lst[d];
      float ecm = __expf(cm), elc = __expf(la - cm);
      if (qtr == 3) EL[((size_t)(((dir * 8 + b) * 4 + h) * 68 + cstep)) * 128 + d] = __expf(la);
#pragma unroll
      for (int i = 0; i < 16; ++i) {
        int tau = qtr * 16 + i;
        float qhat = qv[i] * __expf(cum[i] - cm);
        float khat = kv[i] * __expf(cm - cum[i]);
        qh[tau * 136 + d] = f2bf(qhat);
        kh[tau * 136 + d] = f2bf(khat);
        ktl[d * 72 + tau] = f2bf(khat * elc);
        int row = chain_row(b, dir, cstep, tau);
        PA[(size_t)row * 2560 + 1024 + dir * 512 + h * 128 + d] = f2bf(qhat * ecm);
      }
    }
    LDS_SYNC();
    {
      int dd = t >> 2, s0 = (t & 3) * 16;
      u32x4 a0 = *(const u32x4*)(ktl + dd * 72 + s0), a1 = *(const u32x4*)(ktl + dd * 72 + s0 + 8);
      u16* dst = NX + (size_t)(rbase + (t >> 3)) * 1536 + 512 + dir * 512 + h * 128 + (t & 7) * 16;
      *(u32x4*)dst = a0;
      *(u32x4*)(dst + 8) = a1;
    }
    {
      int tt = w >> 1;
#pragma unroll
      for (int u = 0; u < 2; ++u) {
        int st = (w & 1) * 2 + u;
        f32x4 a = f32x4{0.f, 0.f, 0.f, 0.f};
        if (st <= tt) {
#pragma unroll
          for (int ks = 0; ks < 4; ++ks)
            a = MFMA(ldfrag(kh, st * 16 + fr, 136, ks * 32 + fq * 8), ldfrag(qh, tt * 16 + fr, 136, ks * 32 + fq * 8), a);
          int tau = tt * 16 + fr;
#pragma unroll
          for (int r = 0; r < 4; ++r) {
            int sg = st * 16 + fq * 4 + r;
            if (sg > tau) a[r] = 0.f;
          }
        }
        *(uint2*)(at + (tt * 16 + fr) * 72 + st * 16 + fq * 4) = pack4(a);
      }
    }
    LDS_SYNC();
    {
      int tt = w >> 1;
      int row = chain_row(b, dir, cstep, tt * 16 + fr);
#pragma unroll
      for (int u = 0; u < 4; ++u) {
        int vt = (w & 1) * 4 + u;
        f32x4 a = f32x4{0.f, 0.f, 0.f, 0.f};
#pragma unroll
        for (int ks = 0; ks < 2; ++ks)
          a = MFMA(ldfrag(vT, vt * 16 + fr, 72, ks * 32 + fq * 8), ldfrag(at, tt * 16 + fr, 72, ks * 32 + fq * 8), a);
        *(uint2*)(OUT + (size_t)row * 512 + h * 128 + vt * 16 + fq * 4) = pack4(a);
      }
    }
  }
}
#undef ISSUE_P

__device__ __forceinline__ void chain_a(const P& p, int l, int item, char* smem) {
  const int t = TID(), lane = t & 63, w = t >> 6;
  const int vs = (item >> 3) & 3, chn = ((item >> 5) << 3) | (item & 7), dir = chn & 1, h = (chn >> 1) & 3, b = chn >> 3;
  u16* qh = (u16*)smem;
  u16* khT = qh + 64 * 136;
  u16* vT = khT + 128 * 72;
  u16* sT = vT + 32 * 72;
  float* lst = (float*)(sT + 32 * 136);
  const u16* PA = (const u16*)(lptr(p.ws) + OFF_R + R_PA);
  const u16* NX = (const u16*)(lptr(p.ws) + OFF_NA);
  const float* EL = (const float*)(lptr(p.ws) + OFF_BA);
  u16* OUT = (u16*)(lptr(p.ws) + OFF_R + (dir == 0 ? R_OF : R_OB));
  const int fr = lane & 15, fq = lane >> 4;
  const int vt = w & 1, tt = w >> 1;
  f32x4 S[2];
  S[0] = f32x4{0.f, 0.f, 0.f, 0.f};
  S[1] = S[0];
  u32x4 pq0, pq1, pk0, pk1;
  unsigned pv0, pv1, po0, po1;
  float pel = 0.f;
#define ISSUE_A(cc)                                                                               \
  {                                                                                               \
    int row = chain_row(b, dir, (cc), t >> 3);                                                    \
    const u16* sq = PA + (size_t)row * 2560 + 1024 + dir * 512 + h * 128 + (t & 7) * 16;          \
    pq0 = *(const u32x4*)sq; pq1 = *(const u32x4*)(sq + 8);                                       \
    const unsigned* vp = (const unsigned*)(PA + (size_t)row * 2560 + 512 + h * 128 + vs * 32 + (t & 7) * 4); \
    pv0 = vp[0]; pv1 = vp[1];                                                                     \
    int cn = dir == 0 ? (cc) : ((cc) < 4 ? 3 - (cc) : 71 - (cc));                                 \
    int rb = cn < 4 ? MLAT + b * 256 + cn * 64 : b * 4096 + (cn - 4) * 64;                        \
    const u16* sk = NX + (size_t)(rb + (t >> 3)) * 1536 + 512 + dir * 512 + h * 128 + (t & 7) * 16; \
    pk0 = *(const u32x4*)sk; pk1 = *(const u32x4*)(sk + 8);                                       \
    int orow = chain_row(b, dir, (cc), tt * 16 + fr);                                             \
    const unsigned* op = (const unsigned*)(OUT + (size_t)orow * 512 + h * 128 + vs * 32 + vt * 16 + fq * 4); \
    po0 = op[0]; po1 = op[1];                                                                     \
    if (t < 128) pel = EL[((size_t)(((dir * 8 + b) * 4 + h) * 68 + (cc))) * 128 + t];             \
  }
  ISSUE_A(0)
  for (int c = 0; c < 68; ++c) {
    LDS_SYNC();
    {
      int tau = t >> 3, d0 = (t & 7) * 16;
      *(u32x4*)(qh + tau * 136 + d0) = pq0;
      *(u32x4*)(qh + tau * 136 + d0 + 8) = pq1;
      int dd = t >> 2, s0 = (t & 3) * 16;
      *(u32x4*)(khT + dd * 72 + s0) = pk0;
      *(u32x4*)(khT + dd * 72 + s0 + 8) = pk1;
      int v4 = (t & 7) * 4;
      vT[(v4 + 0) * 72 + tau] = (u16)(pv0 & 0xffff);
      vT[(v4 + 1) * 72 + tau] = (u16)(pv0 >> 16);
      vT[(v4 + 2) * 72 + tau] = (u16)(pv1 & 0xffff);
      vT[(v4 + 3) * 72 + tau] = (u16)(pv1 >> 16);
      if (t < 128) lst[t] = pel;
#pragma unroll
      for (int v2 = 0; v2 < 2; ++v2) *(uint2*)(sT + (v2 * 16 + fr) * 136 + w * 16 + fq * 4) = pack4(S[v2]);
    }
    const unsigned oi0 = po0, oi1 = po1;
    const int crow = chain_row(b, dir, c, tt * 16 + fr);
    LDS_SYNC();
    if (c + 1 < 68) ISSUE_A(c + 1)
    {
      f32x4 a = f32x4{0.f, 0.f, 0.f, 0.f};
#pragma unroll
      for (int ks = 0; ks < 4; ++ks)
        a = MFMA(ldfrag(sT, vt * 16 + fr, 136, ks * 32 + fq * 8), ldfrag(qh, tt * 16 + fr, 136, ks * 32 + fq * 8), a);
      a[0] += bf2f((u16)(oi0 & 0xffff));
      a[1] += bf2f((u16)(oi0 >> 16));
      a[2] += bf2f((u16)(oi1 & 0xffff));
      a[3] += bf2f((u16)(oi1 >> 16));
      *(uint2*)(OUT + (size_t)crow * 512 + h * 128 + vs * 32 + vt * 16 + fq * 4) = pack4(a);
#pragma unroll
      for (int v2 = 0; v2 < 2; ++v2) {
        f32x4 ds = f32x4{0.f, 0.f, 0.f, 0.f};
#pragma unroll
        for (int ks = 0; ks < 2; ++ks)
          ds = MFMA(ldfrag(khT, w * 16 + fr, 72, ks * 32 + fq * 8), ldfrag(vT, v2 * 16 + fr, 72, ks * 32 + fq * 8), ds);
#pragma unroll
        for (int r = 0; r < 4; ++r) S[v2][r] = lst[w * 16 + fq * 4 + r] * S[v2][r] + ds[r];
      }
    }
  }
}
#undef ISSUE_A

__device__ __forceinline__ void normgate(const P& p, int l, int item, int which) {
  const int t = TID(), lane = t & 63, w = t >> 6;
  const int row0 = item * 16 + w * 2;
  char* R = lptr(p.ws) + OFF_R;
  const u16 *ofb, *obb, *gtb;
  int so, sg;
  const float* nw;
  u16* outb;
  if (which == 0) {
    ofb = (const u16*)(R + R_OF); obb = (const u16*)(R + R_OB); so = 512;
    gtb = (const u16*)(R + R_PA) + 2048; sg = 2560;
    nw = lptr(p.in[9]) + l * 128;
    outb = (u16*)(lptr(p.ws) + OFF_NA);
  } else {
    ofb = (const u16*)(R + R_PB) + 512; obb = (const u16*)(R + R_PB) + 1024; so = 2304;
    gtb = (const u16*)(R + R_PB) + 1536; sg = 2304;
    nw = lptr(p.in[13]) + l * 128;
    outb = (u16*)(lptr(p.ws) + OFF_NA) + 512;
  }
  unsigned a[2][4], bb[2][4], g[2][4];
#pragma unroll
  for (int r = 0; r < 2; ++r)
#pragma unroll
    for (int h = 0; h < 4; ++h) {
      int c = h * 128 + lane * 2;
      a[r][h] = *(const unsigned*)(ofb + (size_t)(row0 + r) * so + c);
      bb[r][h] = *(const unsigned*)(obb + (size_t)(row0 + r) * so + c);
      g[r][h] = *(const unsigned*)(gtb + (size_t)(row0 + r) * sg + c);
    }
  const float w0 = nw[lane * 2], w1 = nw[lane * 2 + 1];
#pragma unroll
  for (int r = 0; r < 2; ++r)
#pragma unroll
    for (int h = 0; h < 4; ++h) {
      float o0 = bf2f((u16)(a[r][h] & 0xffff)) + bf2f((u16)(bb[r][h] & 0xffff));
      float o1 = bf2f((u16)(a[r][h] >> 16)) + bf2f((u16)(bb[r][h] >> 16));
      float ss = wsum(o0 * o0 + o1 * o1);
      float rstd = rsqrtf(ss * (1.f / 128.f) + 1e-6f);
      float g0 = bf2f((u16)(g[r][h] & 0xffff)), g1 = bf2f((u16)(g[r][h] >> 16));
      *(unsigned*)(outb + (size_t)(row0 + r) * 1536 + h * 128 + lane * 2) = pack2(o0 * rstd * w0 * siluf(g0), o1 * rstd * w1 * siluf(g1));
    }
}

__device__ __forceinline__ void conv_b(const P& p, int l, int item) {
  const int t = TID(), lane = t & 63, w = t >> 6;
  const int u = item * 8 + w;
  const int tile = u / 12, slot = u % 12;
  const u16* PB = (const u16*)(lptr(p.ws) + OFF_R + R_PB);
  u16* Q = (u16*)(lptr(p.ws) + OFF_R + R_QKV);
  const int row0 = tile * 16;
  int pos0, len;
  if (row0 < MLAT) { pos0 = row0 & 4095; len = 4096; }
  else { pos0 = (row0 - MLAT) & 255; len = 256; }
  const int ch = slot * 128 + lane * 2;
  const float* cw = lptr(p.in[10]) + (size_t)l * 5 * 1536;
  float w0[5], w1[5];
#pragma unroll
  for (int j = 0; j < 5; ++j) { w0[j] = cw[j * 1536 + ch]; w1[j] = cw[j * 1536 + ch + 1]; }
  unsigned raw[20];
#pragma unroll
  for (int i = 0; i < 20; ++i) {
    int pp = pos0 + i - 2;
    raw[i] = (pp >= 0 && pp < len) ? *(const unsigned*)(PB + (size_t)(row0 + i - 2) * 2304 + ch) : 0u;
  }
#pragma unroll
  for (int i = 0; i < 16; ++i) {
    float a0 = 0.f, a1 = 0.f;
#pragma unroll
    for (int j = 0; j < 5; ++j) {
      a0 += w0[j] * bf2f((u16)(raw[i + j] & 0xffff));
      a1 += w1[j] * bf2f((u16)(raw[i + j] >> 16));
    }
    a0 = siluf(a0);
    a1 = siluf(a1);
    if (slot < 8) {
      float ss = wsum(a0 * a0 + a1 * a1);
      float sc = rsqrtf(ss + 1e-6f);
      if (slot < 4) sc *= 0.08838834764831845f;
      a0 *= sc;
      a1 *= sc;
    }
    *(unsigned*)(Q + (size_t)(row0 + i) * 1536 + ch) = pack2(a0, a1);
  }
}

__device__ __forceinline__ void gdn_bg(const P& p, int l, int row, int dir, int h, float& beta, float& g) {
  const float* BA = (const float*)(lptr(p.ws) + OFF_BA) + (size_t)row * 16;
  beta = sigm(BA[dir * 4 + h]);
  float a = BA[8 + dir * 4 + h] + lptr(p.in[12])[(l * 2 + dir) * 4 + h];
  float sp = a > 20.f ? a : log1pf(expf(a));
  g = -expf(lptr(p.in[11])[(l * 2 + dir) * 4 + h]) * sp;
}

__device__ __forceinline__ void tphase_b(const P& p, int l, char* smem) {
  const int t = TID(), lane = t & 63, w = t >> 6;
  u16* ks = (u16*)smem;
  float* Am = (float*)(ks + 64 * 136);
  float* Tm = Am + 64 * 68;
  float* Wm = Tm + 64 * 68;
  float* cumL = Wm + 16 * 68;
  float* betL = cumL + 64;
  const u16* Q = (const u16*)(lptr(p.ws) + OFF_R + R_QKV);
  u16* PB = (u16*)(lptr(p.ws) + OFF_R + R_PB);
  float* BAw = (float*)(lptr(p.ws) + OFF_BA);
  u32x4 pa0, pa1;
  float pbeta = 0.f, pav = 0.f;
#define ISSUE_T(it)                                                                          \
  {                                                                                          \
    const int c_ = (it) % 68, rest_ = (it) / 68;                                             \
    const int dir_ = rest_ & 1, h_ = (rest_ >> 1) & 3, b_ = rest_ >> 3;                      \
    int row_ = chain_row(b_, dir_, c_, t >> 3);                                              \
    const u16* src_ = Q + (size_t)row_ * 1536 + 512 + h_ * 128 + (t & 7) * 16;               \
    pa0 = *(const u32x4*)src_; pa1 = *(const u32x4*)(src_ + 8);                              \
    if (t < 64) {                                                                            \
      int rowt_ = chain_row(b_, dir_, c_, t);                                                \
      pbeta = BAw[(size_t)rowt_ * 16 + dir_ * 4 + h_];                                       \
      pav = BAw[(size_t)rowt_ * 16 + 8 + dir_ * 4 + h_];                                     \
    }                                                                                        \
  }
  int item = blockIdx.x;
  if (item < 4352) ISSUE_T(item)
#pragma unroll 1
  for (; item < 4352; item += gridDim.x) {
  const int c = item % 68;
  const int rest = item / 68;
  const int dir = rest & 1, h = (rest >> 1) & 3, b = rest >> 3;
  LDS_SYNC();
  {
    int tau = t >> 3, d0 = (t & 7) * 16;
    *(u32x4*)(ks + tau * 136 + d0) = pa0;
    *(u32x4*)(ks + tau * 136 + d0 + 8) = pa1;
  }
  for (int e = t; e < 64 * 68; e += NT) Tm[e] = 0.f;
  if (t < 64) {
    int row = chain_row(b, dir, c, t);
    float beta = sigm(pbeta);
    float av = pav + lptr(p.in[12])[(l * 2 + dir) * 4 + h];
    float ex = __expf(av);
    float sp = av > 20.f ? av : (ex < 1e-3f ? ex * (1.f - 0.5f * ex) : __logf(1.f + ex));
    float g = -expf(lptr(p.in[11])[(l * 2 + dir) * 4 + h]) * sp;
    float cs = g;
#pragma unroll
    for (int o = 1; o < 64; o <<= 1) {
      float n = __shfl_up(cs, o, 64);
      if (lane >= o) cs += n;
    }
    cumL[t] = cs;
    betL[t] = beta;
    BAw[(size_t)row * 16 + 8 + dir * 4 + h] = cs;
  }
  if (item + (int)gridDim.x < 4352) ISSUE_T(item + (int)gridDim.x)
  LDS_SYNC();
  {
    const int fr = lane & 15, fq = lane >> 4;
    int tt = w >> 1;
#pragma unroll
    for (int u = 0; u < 2; ++u) {
      int st = (w & 1) * 2 + u;
      f32x4 a = f32x4{0.f, 0.f, 0.f, 0.f};
      if (st <= tt) {
#pragma unroll
        for (int k2 = 0; k2 < 4; ++k2)
          a = MFMA(ldfrag(ks, st * 16 + fr, 136, k2 * 32 + fq * 8), ldfrag(ks, tt * 16 + fr, 136, k2 * 32 + fq * 8), a);
      }
      int tau = tt * 16 + fr;
      float ct = cumL[tau], bt = betL[tau];
      f32x4 o;
#pragma unroll
      for (int r = 0; r < 4; ++r) {
        int sg = st * 16 + fq * 4 + r;
        o[r] = (sg < tau) ? bt * a[r] * __expf(ct - cumL[sg]) : 0.f;
      }
      *(f32x4*)(Am + tau * 68 + st * 16 + fq * 4) = o;
    }
  }
  LDS_SYNC();
  if (w < 4 && lane < 16) {
    const int I = w, cc = lane;
    float x[16];
#pragma unroll
    for (int i = 0; i < 16; ++i) {
      const f32x4* ap = (const f32x4*)(Am + (16 * I + i) * 68 + 16 * I);
      f32x4 a0 = ap[0], a1 = ap[1], a2 = ap[2], a3 = ap[3];
      const float aa[16] = {a0[0], a0[1], a0[2], a0[3], a1[0], a1[1], a1[2], a1[3], a2[0], a2[1], a2[2], a2[3], a3[0], a3[1], a3[2], a3[3]};
      float sacc = (i == cc) ? 1.f : 0.f;
#pragma unroll
      for (int ip = 0; ip < 16; ++ip)
        if (ip < i) sacc -= aa[ip] * x[ip];
      x[i] = sacc;
      Tm[(16 * I + i) * 68 + 16 * I + cc] = sacc;
    }
  }
  LDS_SYNC();
#pragma unroll 1
  for (int I = 1; I < 4; ++I) {
    for (int o = t; o < 256 * I; o += NT) {
      const int i = o & 15, cc = o >> 4;
      float sacc = 0.f;
      const float* arow = Am + (16 * I + i) * 68;
#pragma unroll 16
      for (int sg = 0; sg < 16 * I; ++sg) sacc += arow[sg] * Tm[sg * 68 + cc];
      Wm[i * 68 + cc] = sacc;
    }
    LDS_SYNC();
    for (int o = t; o < 256 * I; o += NT) {
      const int i = o & 15, cc = o >> 4;
      float sacc = 0.f;
      const float* trow = Tm + (16 * I + i) * 68 + 16 * I;
#pragma unroll
      for (int ip = 0; ip < 16; ++ip) sacc -= trow[ip] * Wm[ip * 68 + cc];
      Tm[(16 * I + i) * 68 + cc] = sacc;
    }
    LDS_SYNC();
  }
  {
    int tau = t >> 3, s0 = (t & 7) * 8;
    int row = chain_row(b, dir, c, tau);
    const float* tr = Tm + tau * 68 + s0;
    u32x4 o, ow;
#pragma unroll
    for (int i = 0; i < 4; ++i) {
      float x0 = tr[2 * i] * betL[s0 + 2 * i], x1 = tr[2 * i + 1] * betL[s0 + 2 * i + 1];
      o[i] = pack2(x0, x1);
      ow[i] = pack2(x0 * __expf(cumL[s0 + 2 * i]), x1 * __expf(cumL[s0 + 2 * i + 1]));
    }
    *(u32x4*)(PB + (size_t)row * 2304 + h * 128 + dir * 64 + s0) = o;
    *(u32x4*)((u16*)(lptr(p.ws) + OFF_NA) + (size_t)row * 1536 + 512 + h * 128 + dir * 64 + s0) = ow;
  }
  }
#undef ISSUE_T
}

__device__ __forceinline__ void chain_b(const P& p, int l, int item, char* smem) {
  const int t = TID(), lane = t & 63, w = t >> 6;
  const int vs = (item >> 3) & 3, chn = ((item >> 5) << 3) | (item & 7), dir = chn & 1, h = (chn >> 1) & 3, b = chn >> 3;
  u16* qs = (u16*)smem;
  u16* ks = qs + 64 * 136;
  u16* wl = ks + 64 * 136;
  u16* kT = wl + 64 * 136;
  u16* Tu = kT + 128 * 72;
  u16* Tw = Tu + 64 * 72;
  u16* at = Tw + 64 * 72;
  u16* vT = at + 64 * 72;
  u16* vnT = vT + 32 * 72;
  u16* vnsT = vnT + 32 * 72;
  u16* sT = vnsT + 32 * 72;
  float* cumL = (float*)(sT + 32 * 136);
  float* ecum = cumL + 64;
  float* elc = ecum + 64;
  float* misc = elc + 64;
  const u16* Q = (const u16*)(lptr(p.ws) + OFF_R + R_QKV);
  u16* PB = (u16*)(lptr(p.ws) + OFF_R + R_PB);
  const int fr = lane & 15, fq = lane >> 4;
  f32x4 S[2];
  S[0] = f32x4{0.f, 0.f, 0.f, 0.f};
  S[1] = S[0];
  u32x4 pq0, pq1, pk0, pk1, ptv, ptw;
  unsigned pv0, pv1;
  float pa = 0.f;
  const u16* NXp = (const u16*)(lptr(p.ws) + OFF_NA);
  const float* BAp = (const float*)(lptr(p.ws) + OFF_BA);
#define ISSUE_B(cc)                                                                               \
  {                                                                                               \
    int row = chain_row(b, dir, (cc), t & 63);                                                    \
    const u16* sq = Q + (size_t)row * 1536 + h * 128 + (t >> 6) * 16;                             \
    pq0 = *(const u32x4*)sq; pq1 = *(const u32x4*)(sq + 8);                                       \
    pk0 = *(const u32x4*)(sq + 512); pk1 = *(const u32x4*)(sq + 520);                             \
    const unsigned* vp = (const unsigned*)(Q + (size_t)row * 1536 + 1024 + h * 128 + vs * 32 + (t >> 6) * 4); \
    pv0 = vp[0]; pv1 = vp[1];                                                                     \
    int rowT = chain_row(b, dir, (cc), t >> 3);                                                   \
    ptv = *(const u32x4*)(PB + (size_t)rowT * 2304 + h * 128 + dir * 64 + (t & 7) * 8);           \
    ptw = *(const u32x4*)(NXp + (size_t)rowT * 1536 + 512 + h * 128 + dir * 64 + (t & 7) * 8);    \
    if (t < 64) {                                                                                 \
      int rowt = chain_row(b, dir, (cc), t);                                                      \
      pa = BAp[(size_t)rowt * 16 + 8 + dir * 4 + h];                                              \
    }                                                                                             \
  }
  ISSUE_B(0)
  for (int c = 0; c < 68; ++c) {
    LDS_SYNC();
    {
      int tauT = t >> 3, s0 = (t & 7) * 8;
      *(u32x4*)(Tu + tauT * 72 + s0) = ptv;
      *(u32x4*)(Tw + tauT * 72 + s0) = ptw;
    }
    {
      int tau = t & 63, d0 = (t >> 6) * 16;
      *(u32x4*)(qs + tau * 136 + d0) = pq0;
      *(u32x4*)(qs + tau * 136 + d0 + 8) = pq1;
      *(u32x4*)(ks + tau * 136 + d0) = pk0;
      *(u32x4*)(ks + tau * 136 + d0 + 8) = pk1;
#pragma unroll
      for (int i = 0; i < 4; ++i) {
        kT[(d0 + 2 * i) * 72 + tau] = (u16)(pk0[i] & 0xffff);
        kT[(d0 + 2 * i + 1) * 72 + tau] = (u16)(pk0[i] >> 16);
        kT[(d0 + 8 + 2 * i) * 72 + tau] = (u16)(pk1[i] & 0xffff);
        kT[(d0 + 8 + 2 * i + 1) * 72 + tau] = (u16)(pk1[i] >> 16);
      }
      int v4 = (t >> 6) * 4;
      vT[(v4 + 0) * 72 + tau] = (u16)(pv0 & 0xffff);
      vT[(v4 + 1) * 72 + tau] = (u16)(pv0 >> 16);
      vT[(v4 + 2) * 72 + tau] = (u16)(pv1 & 0xffff);
      vT[(v4 + 3) * 72 + tau] = (u16)(pv1 >> 16);
    }
    if (t < 64) {
      float cs = pa;
      float last = __shfl(cs, 63, 64);
      cumL[t] = cs;
      ecum[t] = __expf(cs);
      elc[t] = __expf(last - cs);
      if (t == 0) misc[0] = __expf(last);
    }
#pragma unroll
    for (int vt = 0; vt < 2; ++vt) *(uint2*)(sT + (vt * 16 + fr) * 136 + w * 16 + fq * 4) = pack4(S[vt]);
    if (c + 1 < 68) ISSUE_B(c + 1)
    LDS_SYNC();
    const int vt = w & 1, tt = w >> 1;
    f32x4 au = f32x4{0.f, 0.f, 0.f, 0.f};
    bf16x8 kfr[2], sfr[4];
    {
#pragma unroll
      for (int u = 0; u < 2; ++u) {
        int st = (w & 1) * 2 + u;
        f32x4 a = f32x4{0.f, 0.f, 0.f, 0.f};
        if (st <= tt) {
#pragma unroll
          for (int k2 = 0; k2 < 4; ++k2)
            a = MFMA(ldfrag(ks, st * 16 + fr, 136, k2 * 32 + fq * 8), ldfrag(qs, tt * 16 + fr, 136, k2 * 32 + fq * 8), a);
          int tau = tt * 16 + fr;
          float ct = cumL[tau];
#pragma unroll
          for (int r = 0; r < 4; ++r) {
            int sg = st * 16 + fq * 4 + r;
            a[r] = (sg <= tau) ? a[r] * __expf(ct - cumL[sg]) : 0.f;
          }
        }
        *(uint2*)(at + (tt * 16 + fr) * 72 + st * 16 + fq * 4) = pack4(a);
      }
#pragma unroll
      for (int k2 = 0; k2 < 2; ++k2)
        au = MFMA(ldfrag(vT, vt * 16 + fr, 72, k2 * 32 + fq * 8), ldfrag(Tu, tt * 16 + fr, 72, k2 * 32 + fq * 8), au);
      kfr[0] = ldfrag(kT, w * 16 + fr, 72, fq * 8);
      kfr[1] = ldfrag(kT, w * 16 + fr, 72, 32 + fq * 8);
#pragma unroll
      for (int t2 = 0; t2 < 4; ++t2) {
        f32x4 a = f32x4{0.f, 0.f, 0.f, 0.f};
#pragma unroll
        for (int k2 = 0; k2 < 2; ++k2)
          a = MFMA(kfr[k2], ldfrag(Tw, t2 * 16 + fr, 72, k2 * 32 + fq * 8), a);
        *(uint2*)(wl + (t2 * 16 + fr) * 136 + w * 16 + fq * 4) = pack4(a);
      }
    }
    LDS_SYNC();
    {
      f32x4 a = f32x4{0.f, 0.f, 0.f, 0.f};
#pragma unroll
      for (int k2 = 0; k2 < 4; ++k2) {
        sfr[k2] = ldfrag(sT, vt * 16 + fr, 136, k2 * 32 + fq * 8);
        a = MFMA(sfr[k2], ldfrag(wl, tt * 16 + fr, 136, k2 * 32 + fq * 8), a);
      }
      int tau = tt * 16 + fr;
      float el = elc[tau];
#pragma unroll
      for (int r = 0; r < 4; ++r) {
        float vn = au[r] - a[r];
        int vv = vt * 16 + fq * 4 + r;
        vnT[vv * 72 + tau] = f2bf(vn);
        vnsT[vv * 72 + tau] = f2bf(vn * el);
      }
    }
    LDS_SYNC();
    {
      f32x4 a1 = f32x4{0.f, 0.f, 0.f, 0.f}, a2 = f32x4{0.f, 0.f, 0.f, 0.f};
#pragma unroll
      for (int k2 = 0; k2 < 4; ++k2)
        a1 = MFMA(sfr[k2], ldfrag(qs, tt * 16 + fr, 136, k2 * 32 + fq * 8), a1);
#pragma unroll
      for (int k2 = 0; k2 < 2; ++k2)
        a2 = MFMA(ldfrag(vnT, vt * 16 + fr, 72, k2 * 32 + fq * 8), ldfrag(at, tt * 16 + fr, 72, k2 * 32 + fq * 8), a2);
      int tau = tt * 16 + fr;
      float ec = ecum[tau];
      f32x4 o;
#pragma unroll
      for (int r = 0; r < 4; ++r) o[r] = ec * a1[r] + a2[r];
      int row = chain_row(b, dir, c, tau);
      *(uint2*)(PB + (size_t)row * 2304 + 512 + dir * 512 + h * 128 + vs * 32 + vt * 16 + fq * 4) = pack4(o);
      float elast = misc[0];
#pragma unroll
      for (int v2 = 0; v2 < 2; ++v2) {
        f32x4 ds = f32x4{0.f, 0.f, 0.f, 0.f};
#pragma unroll
        for (int k2 = 0; k2 < 2; ++k2)
          ds = MFMA(kfr[k2], ldfrag(vnsT, v2 * 16 + fr, 72, k2 * 32 + fq * 8), ds);
#pragma unroll
        for (int r = 0; r < 4; ++r) S[v2][r] = elast * S[v2][r] + ds[r];
      }
    }
  }
}
#undef ISSUE_B

__device__ __forceinline__ void s5_tables(const P& p, int l, int item, char* smem) {
  const int t = TID();
  char* R = lptr(p.ws) + OFF_R;
  if (item < 512) {
    const int g = item >> 4, tb = item & 15;
    float2* pw = (float2*)smem;
    float2* Cc = pw + 512;
    __syncthreads();
    {
      int tl = t >> 7, dirx = (t >> 6) & 1, s0 = t & 63;
      int tau = tb * 4 + tl;
      S5c c = s5_load(p, l, dirx, g, s0);
      float pr, pi;
      s5_pow(c, dirx == 0 ? tau + 1 : 64 - tau, pr, pi);
      pw[t] = float2{pr, pi};
    }
    for (int e = t; e < 1024; e += NT) {
      int co = e >> 6, s2 = e & 63;
      Cc[e] = float2{lptr(p.in[19])[((size_t)(l * 32 + g) * 16 + co) * 64 + s2], lptr(p.in[20])[((size_t)(l * 32 + g) * 16 + co) * 64 + s2]};
    }
    __syncthreads();
    const float* KT = (const float*)(lptr(p.ws) + OFF_KT);
    u16* BP = (u16*)(R + R_BP);
    const int k = 2 * t, sg = k >> 4, ci = k & 15;
#pragma unroll 1
    for (int tl = 0; tl < 4; ++tl) {
      const int tau = tb * 4 + tl;
#pragma unroll 8
      for (int co = 0; co < 16; ++co) {
        float v0 = 0.f, v1 = 0.f;
        if (sg <= tau) { float2 a = *(const float2*)(KT + ((size_t)((0 * 32 + g) * 64 + (tau - sg))) * 256 + co * 16 + ci); v0 += a.x; v1 += a.y; }
        if (sg >= tau) { float2 a = *(const float2*)(KT + ((size_t)((1 * 32 + g) * 64 + (sg - tau))) * 256 + co * 16 + ci); v0 += a.x; v1 += a.y; }
        if (sg == tau) { float dsk = lptr(p.in[21])[l * 512 + g * 16 + co]; if (co == ci) v0 += dsk; if (co == ci + 1) v1 += dsk; }
        u16* rowp = BP + ((size_t)(g * 1024 + tau * 16 + co)) * 1280;
        *(unsigned*)(rowp + k) = pack2(v0, v1);
        if (t < 128) {
          int kk = 2 * t;
          int dirx = kk >> 7, si = kk & 127, s2 = si & 63, isim = si >> 6;
          float2 cA = Cc[co * 64 + s2], cB = Cc[co * 64 + s2 + 1];
          float2 pA = pw[(tl * 2 + dirx) * 64 + s2], pB = pw[(tl * 2 + dirx) * 64 + s2 + 1];
          float reA = cA.x * pA.x - cA.y * pA.y, imA = cA.x * pA.y + cA.y * pA.x;
          float reB = cB.x * pB.x - cB.y * pB.y, imB = cB.x * pB.y + cB.y * pB.x;
          *(unsigned*)(rowp + 1024 + kk) = isim ? pack2(-imA, -imB) : pack2(reA, reB);
        }
      }
    }
  } else {
    item -= 512;
    const int sb = item & 7, g = (item >> 3) & 31, dir = item >> 8;
    float2* pc = (float2*)smem;
    __syncthreads();
    {
      int sl = t >> 6, s0 = t & 63;
      int sg = sb * 8 + sl;
      S5c c = s5_load(p, l, dir, g, s0);
      float pr, pi, cr, ci;
      s5_pow(c, dir == 0 ? 63 - sg : sg, pr, pi);
      s5_coef(c, cr, ci);
      pc[t] = float2{pr * cr - pi * ci, pr * ci + pi * cr};
    }
    __syncthreads();
    u16* M1 = (u16*)(R + R_M1);
    const float* bre = lptr(p.in[17]) + (size_t)(l * 32 + g) * 1024;
    const float* bim = lptr(p.in[18]) + (size_t)(l * 32 + g) * 1024;
#pragma unroll 8
    for (int e = t; e < 16384; e += NT) {
      int n = e >> 7, kk = e & 127, sl = kk >> 4, ci2 = kk & 15;
      int s0 = n & 63, isim = n >> 6;
      float br = bre[s0 * 16 + ci2], bi = bim[s0 * 16 + ci2];
      float2 q = pc[sl * 64 + s0];
      float v = isim ? (q.x * bi + q.y * br) : (q.x * br - q.y * bi);
      M1[((size_t)((dir * 32 + g) * 128 + n)) * 1024 + sb * 128 + kk] = f2bf(v);
    }
  }
}

__device__ __forceinline__ void s5_state(const P& p, int tile, char* smem) {
  char* R = lptr(p.ws) + OFF_R;
  const int dg = tile / 3, tm = tile % 3;
  const int g = dg & 31;
  f32x4 acc[4][4];
  zero_acc(acc);
  gemm_loop((const u16*)(R + R_UG) + ((size_t)(g * 768 + tm * 256)) * 1280, 1280,
            (const u16*)(R + R_M1) + (size_t)dg * 128 * 1024, 1024, 1024, smem, acc);
  float* DS = (float*)(R + R_DS);
  EPI_LOOP({
    int chunk = tm * 256 + ml;
    if (chunk < 544) *(float4*)(DS + ((size_t)(dg * 768 + chunk)) * 128 + nl) = float4{v[0], v[1], v[2], v[3]};
  })
}

__device__ __forceinline__ void s5_scan(const P& p, int l, int item) {
  const int id = item * NT + TID();
  const int s = id & 63, g = (id >> 6) & 31, dir = (id >> 11) & 1, b = id >> 12;
  char* R = lptr(p.ws) + OFF_R;
  S5c c = s5_load(p, l, dir, g, s);
  float a_r, a_i;
  s5_pow(c, 64, a_r, a_i);
  const float* DS = (const float*)(R + R_DS);
  u16* UG = (u16*)(R + R_UG);
  float xr = 0.f, xi = 0.f;
#pragma unroll 1
  for (int bt = 0; bt < 4; ++bt) {
    float dr[17], di[17];
#pragma unroll
    for (int i = 0; i < 17; ++i) {
      int step = bt * 17 + i;
      int c68 = dir == 0 ? step : (step < 4 ? 3 - step : 71 - step);
      const float* dp = DS + ((size_t)((dir * 32 + g) * 768 + b * 68 + c68)) * 128;
      dr[i] = dp[s];
      di[i] = dp[64 + s];
    }
#pragma unroll
    for (int i = 0; i < 17; ++i) {
      int step = bt * 17 + i;
      int c68 = dir == 0 ? step : (step < 4 ? 3 - step : 71 - step);
      u16* up = UG + ((size_t)(g * 768 + b * 68 + c68)) * 1280 + 1024 + dir * 128;
      up[s] = f2bf(xr);
      up[64 + s] = f2bf(xi);
      float nr = a_r * xr - a_i * xi + dr[i];
      float ni = a_r * xi + a_i * xr + di[i];
      xr = nr;
      xi = ni;
    }
  }
}

__device__ __forceinline__ void final_norm(const P& p, int item) {
  const int t = TID(), lane = t & 63, w = t >> 6;
  const int r = item * 8 + w;
  float* xr = lptr(p.out) + (size_t)r * 1024;
  float4 v[4];
  float ss = 0.f;
#pragma unroll
  for (int i = 0; i < 4; ++i) {
    v[i] = *(const float4*)(xr + i * 256 + lane * 4);
    ss += v[i].x * v[i].x + v[i].y * v[i].y + v[i].z * v[i].z + v[i].w * v[i].w;
  }
  ss = wsum(ss);
  float rstd = rsqrtf(ss * (1.f / 1024.f) + 1e-6f);
#pragma unroll
  for (int i = 0; i < 4; ++i) {
    int c = i * 256 + lane * 4;
    float4 wv = *(const float4*)(lptr(p.in[30]) + c);
    float4 o{v[i].x * rstd * wv.x, v[i].y * rstd * wv.y, v[i].z * rstd * wv.z, v[i].w * rstd * wv.w};
    *(float4*)(xr + c) = o;
  }
}

struct OrderStatic {
  int nM, nN, nwg, G, c;
  __device__ void init(int M, int N, int G_, int c_) { nM = M / 256; nN = N / 256; nwg = nM * nN; G = G_; c = c_; }
  __device__ bool next(int i, pg8::Unit& u) const {
    const long L = (long)i * G + c;
    if (L >= nwg) return false;
    int wgid = (int)L;
    { const int q = nwg / 8, r = nwg % 8, xcd = wgid % 8, off = wgid / 8; wgid = (xcd < r ? xcd * (q + 1) : r * (q + 1) + (xcd - r) * q) + off; }
    const int nig = 8 * nN, gid = wgid / nig, fm = gid * 8, gsz = (nM - fm) < 8 ? (nM - fm) : 8;
    u.pm = fm + ((wgid % nig) % gsz);
    u.pn = (wgid % nig) / gsz;
    return true;
  }
  __device__ __forceinline__ void a_ready(const pg8::Unit&) const {}
  __device__ __forceinline__ void done(const pg8::Unit&) const {}
};
struct OrderS5 {
  int G, c;
  __device__ bool next(int i, pg8::Unit& u) const {
    int L = i * G + c;
    if (L >= 384) return false;
    int g = L / 12, rem = L % 12;
    u.pm = g * 3 + (rem >> 2);
    u.pn = g * 4 + (rem & 3);
    return true;
  }
  __device__ __forceinline__ void a_ready(const pg8::Unit&) const {}
  __device__ __forceinline__ void done(const pg8::Unit&) const {}
};

#define PG_EPI_LOOP(...)                                                                   \
  _Pragma("unroll") for (int ai = 0; ai < 2; ++ai)                                         \
  _Pragma("unroll") for (int m = 0; m < 4; ++m)                                            \
  _Pragma("unroll") for (int bj = 0; bj < 2; ++bj)                                         \
  _Pragma("unroll") for (int n = 0; n < 2; ++n) {                                          \
    const int row = u.pm * 256 + ai * 128 + wr * 64 + m * 16 + fr;                         \
    const int col = u.pn * 256 + bj * 128 + wc * 32 + n * 16 + 4 * fq;                     \
    f32x4 v = acc[ai][bj][m][n];                                                           \
    __VA_ARGS__                                                                            \
  }
#define PG_EPI_LOOP8(...)                                                                  \
  _Pragma("unroll") for (int ai = 0; ai < 2; ++ai)                                         \
  _Pragma("unroll") for (int m = 0; m < 4; ++m)                                            \
  _Pragma("unroll") for (int bj = 0; bj < 2; ++bj) {                                       \
    const int row = u.pm * 256 + ai * 128 + wr * 64 + m * 16 + fr;                         \
    const int col = u.pn * 256 + bj * 128 + wc * 32 + 8 * fq;                              \
    f32x4 v0 = acc[ai][bj][m][0], v1 = acc[ai][bj][m][1];                                  \
    __VA_ARGS__                                                                            \
  }
__device__ __forceinline__ u32x4 pack8(f32x4 a, f32x4 b) { uint2 p0 = pack4(a), p1 = pack4(b); u32x4 r; r[0] = p0.x; r[1] = p0.y; r[2] = p1.x; r[3] = p1.y; return r; }
__device__ __forceinline__ void unpack8(u32x4 g, f32x4& a, f32x4& b) {
  a[0] = bf2f((u16)(g[0] & 0xffff)); a[1] = bf2f((u16)(g[0] >> 16)); a[2] = bf2f((u16)(g[1] & 0xffff)); a[3] = bf2f((u16)(g[1] >> 16));
  b[0] = bf2f((u16)(g[2] & 0xffff)); b[1] = bf2f((u16)(g[2] >> 16)); b[2] = bf2f((u16)(g[3] & 0xffff)); b[3] = bf2f((u16)(g[3] >> 16));
}
#define PG_EPI_SIG const f32x4 (&acc)[2][2][4][2], const pg8::Unit& u, int wr, int wc, int fr, int fq

template <int MODE> struct EpiStore {
  static constexpr bool PERM = true, AFTER_DRAIN = false, RESCALE = false;
  u16* C; int ldc; float* BA;
  __device__ __forceinline__ void operator()(PG_EPI_SIG) const {
    _Pragma("unroll") for (int ai = 0; ai < 2; ++ai)
    _Pragma("unroll") for (int m = 0; m < 4; ++m)
    _Pragma("unroll") for (int bj = 0; bj < 2; ++bj) {
      const int row = u.pm * 256 + ai * 128 + wr * 64 + m * 16 + fr;
      const int col = u.pn * 256 + bj * 128 + wc * 32 + 8 * fq;
      f32x4 v0 = acc[ai][bj][m][0], v1 = acc[ai][bj][m][1];
      f32x4 o0 = v0, o1 = v1;
      if (MODE == 3) { _Pragma("unroll") for (int r = 0; r < 4; ++r) { o0[r] = sigm(v0[r]); o1[r] = sigm(v1[r]); } }
      if (MODE == 4) { _Pragma("unroll") for (int r = 0; r < 4; ++r) { float x = fmaxf(v0[r], 0.f); o0[r] = x * x; float y = fmaxf(v1[r], 0.f); o1[r] = y * y; } }
      uint2 p0 = pack4(o0), p1 = pack4(o1);
      u32x4 pk; pk[0] = p0.x; pk[1] = p0.y; pk[2] = p1.x; pk[3] = p1.y;
      *(u32x4*)(C + (size_t)row * ldc + col) = pk;
      if (MODE == 1) {
        if (col >= 2048 && col < 2064) {
          float* bp = BA + (size_t)row * 16 + (col - 2048);
          *(f32x4*)bp = v0;
          *(f32x4*)(bp + 4) = v1;
        }
      }
    }
  }
};
struct EpiUg {
  static constexpr bool PERM = true, AFTER_DRAIN = false, RESCALE = false;
  u16* UG;
  __device__ __forceinline__ void operator()(PG_EPI_SIG) const {
    PG_EPI_LOOP8({
      int chunk, tau;
      if (row < MLAT) { int b = row >> 12, tt = row & 4095; chunk = b * 68 + 4 + (tt & 63); tau = tt >> 6; }
      else { int mm = row - MLAT; int b = mm >> 8, jj = mm & 255; chunk = b * 68 + (jj >> 6); tau = jj & 63; }
      int g = col >> 4, ci = col & 15;
      *(u32x4*)(UG + ((size_t)(g * 768 + chunk)) * 1280 + tau * 16 + ci) = pack8(v0, v1);
    })
  }
};
struct EpiGlu {
  static constexpr bool PERM = true, AFTER_DRAIN = false, RESCALE = false;
  const u16* ZC; u16* GL;
  __device__ __forceinline__ void operator()(PG_EPI_SIG) const {
    const int rowb = u.pm * 256 + wr * 64 + fr;
    const int colb = u.pn * 256 + wc * 32 + 8 * fq;
    _Pragma("unroll") for (int ai = 0; ai < 2; ++ai) {
      u32x4 z[4][2];
      _Pragma("unroll") for (int m = 0; m < 4; ++m)
      _Pragma("unroll") for (int bj = 0; bj < 2; ++bj)
        z[m][bj] = *(const u32x4*)(ZC + (size_t)(rowb + ai * 128 + m * 16) * 512 + colb + bj * 128);
      _Pragma("unroll") for (int m = 0; m < 4; ++m)
      _Pragma("unroll") for (int bj = 0; bj < 2; ++bj) {
        f32x4 z0, z1;
        unpack8(z[m][bj], z0, z1);
        f32x4 v0 = acc[ai][bj][m][0], v1 = acc[ai][bj][m][1];
        _Pragma("unroll") for (int r = 0; r < 4; ++r) { z0[r] *= sigm(v0[r]); z1[r] *= sigm(v1[r]); }
        *(u32x4*)(GL + (size_t)(rowb + ai * 128 + m * 16) * 1536 + colb + bj * 128) = pack8(z0, z1);
      }
    }
  }
};
struct EpiMix {
  static constexpr bool PERM = true, AFTER_DRAIN = false, RESCALE = true;
  const u16* PG; u16* MIX;
  __device__ __forceinline__ void rescale(f32x4 (&acc)[2][2][4][2], const pg8::Unit& u, int wr, int wc, int fr, int fq, int nb) const {
    int frl = fr;
    asm volatile("" : "+v"(frl));
    const unsigned base = (unsigned)((u.pm * 256 + wr * 64 + frl) * 3072 + u.pn * 256 + wc * 32 + 8 * fq + (nb - 1) * 1024);
    const u16* pgb = lptr(PG);
    _Pragma("unroll") for (int ai = 0; ai < 2; ++ai) {
      u32x4 ga[4][2], gb[4][2];
      _Pragma("unroll") for (int m = 0; m < 4; ++m)
      _Pragma("unroll") for (int bj = 0; bj < 2; ++bj) {
        const unsigned off = base + (unsigned)((ai * 128 + m * 16) * 3072 + bj * 128);
        ga[m][bj] = *(const u32x4*)(pgb + off);
        gb[m][bj] = *(const u32x4*)(pgb + off + 1024);
      }
      _Pragma("unroll") for (int m = 0; m < 4; ++m)
      _Pragma("unroll") for (int bj = 0; bj < 2; ++bj) {
        f32x4 a0, a1, b0, b1;
        unpack8(ga[m][bj], a0, a1);
        unpack8(gb[m][bj], b0, b1);
        f32x4 v0 = acc[ai][bj][m][0], v1 = acc[ai][bj][m][1];
        _Pragma("unroll") for (int r = 0; r < 4; ++r) {
          v0[r] *= a0[r] * __builtin_amdgcn_rcpf(fmaxf(b0[r], 1e-20f));
          v1[r] *= a1[r] * __builtin_amdgcn_rcpf(fmaxf(b1[r], 1e-20f));
        }
        acc[ai][bj][m][0] = v0;
        acc[ai][bj][m][1] = v1;
      }
      __builtin_amdgcn_sched_barrier(0);
    }
  }
  __device__ __forceinline__ void operator()(PG_EPI_SIG) const {
    const int rowb = u.pm * 256 + wr * 64 + fr;
    const int colb = u.pn * 256 + wc * 32 + 8 * fq;
    _Pragma("unroll") for (int ai = 0; ai < 2; ++ai) {
      u32x4 gq[4][2];
      _Pragma("unroll") for (int m = 0; m < 4; ++m)
      _Pragma("unroll") for (int bj = 0; bj < 2; ++bj)
        gq[m][bj] = *(const u32x4*)(PG + (size_t)(rowb + ai * 128 + m * 16) * 3072 + 2048 + colb + bj * 128);
      _Pragma("unroll") for (int m = 0; m < 4; ++m)
      _Pragma("unroll") for (int bj = 0; bj < 2; ++bj) {
        f32x4 g0, g1;
        unpack8(gq[m][bj], g0, g1);
        f32x4 v0 = acc[ai][bj][m][0], v1 = acc[ai][bj][m][1];
        _Pragma("unroll") for (int r = 0; r < 4; ++r) { g0[r] *= v0[r]; g1[r] *= v1[r]; }
        *(u32x4*)(MIX + (size_t)(rowb + ai * 128 + m * 16) * 1024 + colb + bj * 128) = pack8(g0, g1);
      }
    }
  }
};
struct EpiRes {
  static constexpr bool PERM = true, AFTER_DRAIN = false, RESCALE = false;
  const float* xin; float* out; float* xc; const float* modsb;
  __device__ __forceinline__ void operator()(PG_EPI_SIG) const {
    const int rowb = u.pm * 256 + wr * 64 + fr;
    const int colb = u.pn * 256 + wc * 32 + 8 * fq;
    const bool lat = rowb < MLAT;
    const float* srcb = lat ? xin + (size_t)rowb * 1024 + colb : xc + (size_t)(rowb - MLAT) * 1024 + colb;
    float* dstb = lat ? out + (size_t)rowb * 1024 + colb : xc + (size_t)(rowb - MLAT) * 1024 + colb;
    const float* gp = modsb + (size_t)mod_idx(rowb) * 6144 + colb;
    f32x4 g[2][2];
    _Pragma("unroll") for (int bj = 0; bj < 2; ++bj) { g[bj][0] = *(const f32x4*)(gp + bj * 128); g[bj][1] = *(const f32x4*)(gp + bj * 128 + 4); }
    _Pragma("unroll") for (int ai = 0; ai < 2; ++ai) {
      f32x4 x[4][2][2];
      _Pragma("unroll") for (int m = 0; m < 4; ++m)
      _Pragma("unroll") for (int bj = 0; bj < 2; ++bj) {
        const float* sp = srcb + (size_t)(ai * 128 + m * 16) * 1024 + bj * 128;
        x[m][bj][0] = *(const f32x4*)sp;
        x[m][bj][1] = *(const f32x4*)(sp + 4);
      }
      _Pragma("unroll") for (int m = 0; m < 4; ++m)
      _Pragma("unroll") for (int bj = 0; bj < 2; ++bj) {
        float* dp = dstb + (size_t)(ai * 128 + m * 16) * 1024 + bj * 128;
        *(f32x4*)dp = x[m][bj][0] + g[bj][0] * acc[ai][bj][m][0];
        *(f32x4*)(dp + 4) = x[m][bj][1] + g[bj][1] * acc[ai][bj][m][1];
      }
    }
  }
};
struct EpiS5Out {
  static constexpr bool PERM = true, AFTER_DRAIN = false, RESCALE = false;
  u16* ZC;
  __device__ __forceinline__ void operator()(PG_EPI_SIG) const {
    const int g = u.pm / 3;
    PG_EPI_LOOP8({
      int chunk = row - g * 768;
      if (chunk < 544) {
        int nn = col - g * 1024;
        int tau = nn >> 4, co = nn & 15;
        int b = chunk / 68, c68 = chunk % 68;
        int orow = c68 < 4 ? MLAT + b * 256 + c68 * 64 + tau : b * 4096 + tau * 64 + (c68 - 4);
        f32x4 z0, z1;
        _Pragma("unroll") for (int r = 0; r < 4; ++r) { z0[r] = geluf(v0[r]); z1[r] = geluf(v1[r]); }
        *(u32x4*)(ZC + (size_t)orow * 512 + g * 16 + co) = pack8(z0, z1);
      }
    })
  }
};

template <class Epi>
__device__ __forceinline__ void run_gemm(const u16* A, const u16* Bt, int M, int N, int K, const Epi& E, char* smem) {
  OrderStatic S;
  S.init(M, N, gridDim.x, blockIdx.x);
  pg8::Gemm g{A, Bt, M, N, K};
  __syncthreads();
  pg8::gemm_phase<Epi, OrderStatic, false>((PG8_LAS unsigned char*)smem, g, S, E, nullptr);
  __syncthreads();
}

__device__ __forceinline__ void gemm_simple(const P& p, int mode, char* smem, int M = MALL) {
  const u16* H = (const u16*)(lptr(p.ws) + OFF_H);
  const u16* WT = (const u16*)(lptr(p.ws) + OFF_WT);
  char* R = lptr(p.ws) + OFF_R;
  if (mode == 0) {
    EpiStore<0> E{(u16*)(R + R_PA), 2560, nullptr};
    run_gemm(H, WT + W_IN, MALL, 2560, 1024, E, smem);
  } else if (mode == 1) {
    EpiStore<1> E{(u16*)(R + R_PB), 2304, (float*)(lptr(p.ws) + OFF_BA)};
    run_gemm(H, WT + W_IN + (size_t)2560 * 1024, MALL, 2304, 1024, E, smem);
  } else if (mode == 2) {
    EpiUg E{(u16*)(R + R_UG)};
    run_gemm(H, WT + W_IN + (size_t)4864 * 1024, MALL, 512, 1024, E, smem);
  } else if (mode == 3) {
    EpiStore<3> E{(u16*)(R + R_PG), 3072, nullptr};
    run_gemm(H, WT + W_IN + (size_t)5376 * 1024, M, 3072, 1024, E, smem);
  } else {
    EpiStore<4> E{(u16*)(R + R_HID), 4096, nullptr};
    run_gemm(H, WT + W_FF1, M, 4096, 1024, E, smem);
  }
}
__device__ __forceinline__ void s5_out(const P& p, char* smem) {
  char* R = lptr(p.ws) + OFF_R;
  OrderS5 S{(int)gridDim.x, (int)blockIdx.x};
  pg8::Gemm g{(const u16*)(R + R_UG), (const u16*)(R + R_BP), 32 * 768, 32 * 1024, 1280};
  EpiS5Out E{(u16*)(R + R_ZC)};
  __syncthreads();
  pg8::gemm_phase<EpiS5Out, OrderS5, false>((PG8_LAS unsigned char*)smem, g, S, E, nullptr);
  __syncthreads();
}
__device__ __forceinline__ void glu_gemm(const P& p, char* smem, int M) {
  char* R = lptr(p.ws) + OFF_R;
  EpiGlu E{(const u16*)(R + R_ZC), (u16*)(lptr(p.ws) + OFF_NA) + 1024};
  run_gemm((const u16*)(R + R_ZC), (const u16*)(lptr(p.ws) + OFF_WT) + W_GLU, M, 512, 512, E, smem);
}
__device__ __forceinline__ void mix_gemm(const P& p, char* smem, int M) {
  const u16* WT = (const u16*)(lptr(p.ws) + OFF_WT);
  EpiMix E{(const u16*)(lptr(p.ws) + OFF_R + R_PG), (u16*)(lptr(p.ws) + OFF_H)};
  run_gemm((const u16*)(lptr(p.ws) + OFF_NA), WT + W_BA, M, 1024, 1536, E, smem);
}
__device__ __forceinline__ void res_gemm(const P& p, int l, int which, char* smem, int M) {
  const u16* WT = (const u16*)(lptr(p.ws) + OFF_WT);
  EpiRes E;
  E.xin = (which == 0 && l == 0) ? lptr(p.in[0]) : lptr(p.out);
  E.out = lptr(p.out);
  E.xc = (float*)(lptr(p.ws) + OFF_XC);
  E.modsb = (const float*)(lptr(p.ws) + OFF_MODS) + (size_t)l * 9 * 6144 + (which == 0 ? 2 : 5) * 1024;
  if (which == 0) run_gemm((const u16*)(lptr(p.ws) + OFF_H), WT + W_O, M, 1024, 1024, E, smem);
  else run_gemm((const u16*)(lptr(p.ws) + OFF_R + R_HID), WT + W_FF2, M, 1024, 4096, E, smem);
}

#define XB_TMO      128
#define XB_XCNT(j)  (256  + 64 * (j))
#define XB_XSUB(j)  (1280 + 64 * (j))
#define XB_XGEN(j)  (2304 + 64 * (j))
#define XB_TOP      3328
#define XB_TOPGEN   3392
#define XCD_BAR_WORDS 3456
#define XB_SPIN_CAP (1u << 21)
#define LAS __attribute__((address_space(3)))

__device__ __forceinline__ unsigned xb_ld(unsigned* p)              { return __hip_atomic_load(p, __ATOMIC_RELAXED, __HIP_MEMORY_SCOPE_AGENT); }
__device__ __forceinline__ unsigned xb_add(unsigned* p, unsigned v) { return __hip_atomic_fetch_add(p, v, __ATOMIC_RELAXED, __HIP_MEMORY_SCOPE_AGENT); }
__device__ __forceinline__ unsigned xb_xcc_id() { return (unsigned)__builtin_amdgcn_s_getreg((3 << 11) | 20) & 0xFu; }
#define XB_SPIN(cond, bar) do { unsigned _sp = 0; while (cond) { __builtin_amdgcn_s_sleep(1); \
    if ((++_sp & 255u) == 0u) { if (xb_ld(&(bar)[XB_TMO])) break; if (_sp > XB_SPIN_CAP) { atomicAdd(&(bar)[XB_TMO], 1u); break; } } } } while (0)

struct XcdBarrier {
    unsigned* bar; unsigned x;
    volatile LAS unsigned* st;
};

__device__ __forceinline__ XcdBarrier xcd_barrier_post(unsigned* bar, volatile LAS unsigned* st) {
    XcdBarrier b; b.bar = bar; b.x = xb_xcc_id(); b.st = st;
    if (TID() == 0) (void)xb_add(&bar[XB_XCNT(b.x)], 1u);
    return b;
}
__device__ __forceinline__ void xcd_barrier_complete(unsigned* bar, unsigned x, unsigned& nloc, unsigned& nx) {
    const unsigned G = gridDim.x * gridDim.y * gridDim.z;
    unsigned sum, cnt, mine, sp = 0u;
    for (;;) {
        sum = 0u; cnt = 0u; mine = 0u;
#pragma unroll
        for (unsigned j = 0; j < 16; ++j) { const unsigned c = xb_ld(&bar[XB_XCNT(j)]); sum += c; cnt += (c > 0u) ? 1u : 0u; mine = (j == x) ? c : mine; }
        if (sum == G) break;
        __builtin_amdgcn_s_sleep(1);
        if ((++sp & 255u) == 0u) { if (xb_ld(&bar[XB_TMO])) break; if (sp > XB_SPIN_CAP) { atomicAdd(&bar[XB_TMO], 1u); break; } }
    }
    nloc = mine > 0u ? mine : 1u; nx = cnt > 0u ? cnt : 1u;
}

__device__ __forceinline__ void xcd_barrier(const XcdBarrier& b) {
    asm volatile("s_waitcnt vmcnt(0)" ::: "memory");
    __syncthreads();
    if (TID() == 0) {
        unsigned* bar = b.bar;
        __builtin_amdgcn_s_waitcnt(0);
        unsigned nloc = b.st[0], nx = b.st[1];
        if (nloc == 0u) { xcd_barrier_complete(bar, b.x, nloc, nx); b.st[0] = nloc; b.st[1] = nx; }
        const unsigned old = xb_add(&bar[XB_XSUB(b.x)], 1u);
        const unsigned gen = old / nloc;
        if (old + 1u == (gen + 1u) * nloc) {
            __builtin_amdgcn_fence(__ATOMIC_RELEASE, "agent");
            asm volatile("s_waitcnt vmcnt(0)" ::: "memory");
            const unsigned og = xb_add(&bar[XB_TOP], 1u);
            const unsigned tg = og / nx;
            if (og + 1u == (tg + 1u) * nx) xb_add(&bar[XB_TOPGEN], 1u);
            else XB_SPIN(xb_ld(&bar[XB_TOPGEN]) == tg, bar);
            __builtin_amdgcn_fence(__ATOMIC_ACQUIRE, "agent");
            xb_add(&bar[XB_XGEN(b.x)], 1u);
            asm volatile("s_waitcnt vmcnt(0)" ::: "memory");
        } else {
            XB_SPIN(xb_ld(&bar[XB_XGEN(b.x)]) == gen, bar);
            __builtin_amdgcn_fence(__ATOMIC_ACQUIRE, "agent");
            asm volatile("s_waitcnt vmcnt(0)" ::: "memory");
        }
    }
    __syncthreads();
}


#define NSUB 20
#ifndef PROBE_MASK
#define PROBE_MASK 0
#endif
#define NPHASE (1 + 2 * NSUB + 1)

__device__ __forceinline__ void run_phase(const P& p, int ph, char* smem) {
  const int bid = blockIdx.x, nb = gridDim.x;
  if (ph == 0) {
    for (int i = bid; i < 449 + 1216 + 512; i += nb) {
      if (i < 449) ph_init(p, i, smem);
      else if (i < 449 + 1216) ph_start(p, 0, i - 449, smem);
      else ph_start(p, 0, 3392 + (i - 449 - 1216), smem);
    }
    return;
  }
  if (ph == NPHASE - 1) { for (int i = bid; i < 4096; i += nb) final_norm(p, i); return; }
  const int l = (ph - 1) / NSUB, sub = (ph - 1) % NSUB;
  const int Mr = (l == 1) ? MLAT : MALL;
  switch (sub) {
    case 0:
      if (l == 0) { for (int i = 1216 + bid; i < 1216 + 2176; i += nb) ph_start(p, l, i, smem); }
      else { for (int i = bid; i < 1216 + 2176 + 512; i += nb) ph_start(p, l, i, smem); }
      break;
    case 1: gemm_simple(p, 0, smem); break;
    case 2: prep_a(p, l, smem); break;
    case 3: for (int i = bid; i < 256; i += nb) chain_a(p, l, i, smem); break;
    case 4: for (int i = bid; i < 2176; i += nb) normgate(p, l, i, 0); break;
    case 5: gemm_simple(p, 1, smem); break;
    case 6: for (int i = bid; i < 3264; i += nb) conv_b(p, l, i); break;
    case 7: tphase_b(p, l, smem); break;
    case 8: for (int i = bid; i < 256; i += nb) chain_b(p, l, i, smem); break;
    case 9: for (int i = bid; i < 2176; i += nb) normgate(p, l, i, 1); break;
    case 10:
      gemm_simple(p, 2, smem);
      for (int i = bid; i < 1024; i += nb) s5_tables(p, l, i, smem);
      break;
    case 11: for (int i = bid; i < 192; i += nb) s5_state(p, i, smem); break;
    case 12: for (int i = bid; i < 64; i += nb) s5_scan(p, l, i); break;
    case 13: s5_out(p, smem); break;
    case 14:
      glu_gemm(p, smem, Mr);
      gemm_simple(p, 3, smem, Mr);
      break;
    case 15: mix_gemm(p, smem, Mr); break;
    case 16: res_gemm(p, l, 0, smem, Mr); break;
    case 17: for (int i = bid; i < Mr / 16; i += nb) norm_rows(p, l, i, 1); break;
    case 18: gemm_simple(p, 4, smem, Mr); break;
    case 19: res_gemm(p, l, 1, smem, Mr); break;
  }
}

__global__ void __launch_bounds__(NT) mega(P p, int ph_lo, int ph_hi) {
  extern __shared__ __attribute__((aligned(16))) char smem[];
  cg::grid_group grid = cg::this_grid();
  unsigned* stw = (unsigned*)(smem + 131072);
  if (threadIdx.x == 0) { stw[0] = 0u; stw[1] = 0u; stw[2] = 0u; stw[3] = 0u; }
  __syncthreads();
  XcdBarrier xb;
  if (ph_hi - ph_lo > 1) xb = xcd_barrier_post((unsigned*)(p.ws + OFF_BAR), (volatile LAS unsigned*)stw);
  for (int ph = ph_lo; ph < ph_hi; ++ph) {
    run_phase(p, ph, smem);
    if (PROBE_MASK != 0 && ph > 0 && ph < NPHASE - 1 && ((PROBE_MASK >> ((ph - 1) % NSUB)) & 1)) { __syncthreads(); run_phase(p, ph, smem); }
    if (ph + 1 < ph_hi) { if (ph == ph_lo) grid.sync(); else xcd_barrier(xb); }
  }
}

extern "C" void kernel_launch(void* const* d_in, const int* in_sizes, int n_in, void* d_out, int out_size, void* d_ws,
                              size_t ws_size, hipStream_t stream) {
  static int grid_blocks = 0;
  if (!grid_blocks) {
    hipFuncSetAttribute((const void*)mega, hipFuncAttributeMaxDynamicSharedMemorySize, LDS_BYTES);
    int dev = 0, cus = 0, per_cu = 0;
    hipGetDevice(&dev);
    hipDeviceGetAttribute(&cus, hipDeviceAttributeMultiprocessorCount, dev);
    hipOccupancyMaxActiveBlocksPerMultiprocessor(&per_cu, mega, NT, LDS_BYTES);
    if (per_cu < 1) per_cu = 1;
    grid_blocks = cus * per_cu;
  }
  P p{};
  for (int i = 0; i < 31; ++i) p.in[i] = (const float*)d_in[i];
  p.out = (float*)d_out;
  p.ws = (char*)d_ws;
#if COOP
  hipMemsetAsync((char*)d_ws + OFF_BAR, 0, XCD_BAR_WORDS * 4, stream);
  int lo = 0, hi = NPHASE;
  void* args[] = {&p, &lo, &hi};
  hipError_t e = hipLaunchCooperativeKernel((void*)mega, dim3(grid_blocks), dim3(NT), args, LDS_BYTES, stream);
  if (e != hipSuccess) fprintf(stderr, "cooperative launch failed: %s (grid %d)\n", hipGetErrorString(e), grid_blocks);
#else
  for (int ph = 0; ph < NPHASE; ++ph) mega<<<grid_blocks, NT, LDS_BYTES, stream>>>(p, ph, ph + 1);
#endif
}
```

```cpp
#include <hip/hip_runtime.h>
#include <hip/hip_cooperative_groups.h>
#include <cstdio>
namespace cg = cooperative_groups;

typedef unsigned short u16;
typedef __attribute__((ext_vector_type(8))) short bf16x8;
typedef __attribute__((ext_vector_type(4))) float f32x4;
typedef __attribute__((ext_vector_type(4))) unsigned int u32x4;

#ifndef COOP
#define COOP 1
#endif

#define NT 512
#define MLAT 32768
#define MALL 34816
#define LDS_BYTES (131072 + 64)

constexpr size_t SZ_WT   = 19922944ull * 2;
constexpr size_t OFF_WT  = 0;
constexpr size_t OFF_H   = OFF_WT + SZ_WT;
constexpr size_t SZ_H    = 34816ull * 1024 * 2;
constexpr size_t SZ_N    = 34816ull * 512 * 2;
constexpr size_t OFF_NA  = OFF_H + SZ_H;
constexpr size_t OFF_NB  = OFF_NA + SZ_N;
constexpr size_t OFF_GL  = OFF_NB + SZ_N;
constexpr size_t OFF_XC  = OFF_GL + SZ_N;
constexpr size_t OFF_MODS = OFF_XC + 2048ull * 1024 * 4;
constexpr size_t OFF_LB  = OFF_MODS + 442368;
constexpr size_t OFF_KT  = OFF_LB + 8192;
constexpr size_t OFF_BA  = OFF_KT + 4194304;
constexpr size_t OFF_R   = OFF_BA + 34816ull * 16 * 4;
constexpr size_t OFF_BAR = OFF_R + 34816ull * 4096 * 2;
constexpr size_t R_PA = 0;
constexpr size_t R_OF = 34816ull * 2560 * 2;
constexpr size_t R_OB = R_OF + SZ_N;
constexpr size_t R_PB = 0;
constexpr size_t R_QKV = 34816ull * 2304 * 2;
constexpr size_t R_UG = 0;
constexpr size_t R_BP = 32ull * 768 * 1280 * 2;
constexpr size_t R_M1 = R_BP + 32ull * 1024 * 1280 * 2;
constexpr size_t R_DS = R_M1 + 64ull * 128 * 1024 * 2;
constexpr size_t R_ZC = 240000000ull;
constexpr size_t R_PG = 0;
constexpr size_t R_HID = 0;
constexpr size_t W_IN = 0, W_FF1 = 8650752, W_FF2 = 12845056, W_O = 17039360, W_BA = 18087936,
                 W_BB = 18612224, W_BC = 19136512, W_GLU = 19660800;

struct P {
  const float* in[31];
  float* out;
  char* ws;
};

__device__ __forceinline__ int TID() { int t = threadIdx.x; asm volatile("" : "+v"(t)); return t; }
template <class T> __device__ __forceinline__ T* lptr(T* q) {
  unsigned long long v = (unsigned long long)q;
  unsigned lo = __builtin_amdgcn_readfirstlane((unsigned)v), hi = __builtin_amdgcn_readfirstlane((unsigned)(v >> 32));
  asm volatile("" : "+s"(lo), "+s"(hi));
  typedef __attribute__((address_space(1))) T GT;
  GT* g = (GT*)(((unsigned long long)hi << 32) | lo);
  return (T*)g;
}

__device__ __forceinline__ u16 f2bf(float f) {
  unsigned u = __float_as_uint(f);
  u += 0x7fffu + ((u >> 16) & 1u);
  return (u16)(u >> 16);
}
__device__ __forceinline__ float bf2f(u16 h) { return __uint_as_float(((unsigned)h) << 16); }
typedef float f2v_t __attribute__((ext_vector_type(2)));
typedef __bf16 bf2v_t __attribute__((ext_vector_type(2)));
__device__ __forceinline__ unsigned pack2(float a, float b) {
  f2v_t v = {a, b};
  bf2v_t r = __builtin_convertvector(v, bf2v_t);
  return __builtin_bit_cast(unsigned, r);
}
__device__ __forceinline__ uint2 pack4(f32x4 v) { uint2 r; r.x = pack2(v[0], v[1]); r.y = pack2(v[2], v[3]); return r; }
__device__ __forceinline__ float dpp_f(float v, const int ctrl_sel) {
  int x = __builtin_bit_cast(int, v), r;
  if (ctrl_sel == 0) r = __builtin_amdgcn_update_dpp(x, x, 0xB1, 0xF, 0xF, false);
  else if (ctrl_sel == 1) r = __builtin_amdgcn_update_dpp(x, x, 0x4E, 0xF, 0xF, false);
  else if (ctrl_sel == 2) r = __builtin_amdgcn_update_dpp(x, x, 0x141, 0xF, 0xF, false);
  else r = __builtin_amdgcn_update_dpp(x, x, 0x140, 0xF, 0xF, false);
  return __builtin_bit_cast(float, r);
}
__device__ __forceinline__ float wsum(float v) {
  v += dpp_f(v, 0);
  v += dpp_f(v, 1);
  v += dpp_f(v, 2);
  v += dpp_f(v, 3);
  v += __shfl_xor(v, 16, 64);
  v += __shfl_xor(v, 32, 64);
  return v;
}
__device__ __forceinline__ float sigm(float x) { return __builtin_amdgcn_rcpf(1.f + __expf(-x)); }
__device__ __forceinline__ float siluf(float x) { return x * __builtin_amdgcn_rcpf(1.f + __expf(-x)); }
__device__ __forceinline__ float geluf(float x) {
  float u = 1.5957691216057308f * (x + 0.044715f * x * x * x);
  return x * __builtin_amdgcn_rcpf(1.f + __expf(-u));
}
__device__ __forceinline__ bf16x8 ldfrag(const u16* base, int row, int stride, int koff) {
  return *(const bf16x8*)(base + row * stride + koff);
}
#define LDS_SYNC() do { asm volatile("s_waitcnt lgkmcnt(0)" ::: "memory"); __builtin_amdgcn_s_barrier(); asm volatile("" ::: "memory"); } while (0)
#define MFMA(a, b, c) __builtin_amdgcn_mfma_f32_16x16x32_bf16(a, b, c, 0, 0, 0)

__device__ __forceinline__ int chain_row(int b, int dir, int c, int tau) {
  if (dir == 0) {
    if (c < 4) return MLAT + b * 256 + c * 64 + tau;
    return b * 4096 + (c - 4) * 64 + tau;
  } else {
    if (c < 4) return MLAT + b * 256 + (3 - c) * 64 + 63 - tau;
    return b * 4096 + (67 - c) * 64 + 63 - tau;
  }
}

namespace pg8 {
#define PG8_LAS __attribute__((address_space(3)))
typedef unsigned short bf16_t;
typedef short bf16x8 __attribute__((ext_vector_type(8)));
typedef float f32x4 __attribute__((ext_vector_type(4)));
typedef unsigned u32x4 __attribute__((ext_vector_type(4)));
constexpr int BM = 256, BK = 64, HALF = 128, HTB = HALF * BK * 2  , STAGE_BYTES = 8 * HTB, NXCD = 8, WGM = 8;

__host__ __device__ __forceinline__ int lds_byte(int r, int c) { const int st = (r >> 4) * 2 + (c >> 5), rr = r & 15, cc = c & 31, ob = rr * 64 + cc * 2; return st * 1024 + (ob ^ (((ob >> 9) & 1) << 5)); }
__host__ __device__ __forceinline__ void stage_rc(int b, int& R, int& C) { const int st = b / 1024, sb = b % 1024, swz = sb ^ (((sb >> 9) & 1) << 5); R = (st >> 1) * 16 + swz / 64; C = (st & 1) * 32 + (swz % 64) / 2; }
__host__ __device__ __forceinline__ int perm32(int rho) { const int n = rho >> 4, i = rho & 15; return 8 * (i >> 2) + 4 * n + (i & 3); }

struct Unit { int pm, pn; };
struct Gemm { const bf16_t* A; const bf16_t* Bt; int M, N, K; };

template <class Epi, class Sched, bool STAMP = false>
__device__ __forceinline__ void gemm_phase(PG8_LAS unsigned char* lds, const Gemm g, const Sched& S, const Epi& E, unsigned long long* stamps) {
    const int tid = TID(), wid = __builtin_amdgcn_readfirstlane(tid >> 6), lane = tid & 63, wr = wid >> 2, wc = wid & 3, fr = lane & 15, fq = lane >> 4;
    const int K = g.K, nt = K / BK;
    int ts_lo = 0, ts_hi = 0, nts = 0; const unsigned long long rt_entry = STAMP ? (unsigned long long)wall_clock64() : 0ull;
#define PG8_STAMP() do { if (STAMP && wid == 0 && nts < 64) { const unsigned long long _c = (unsigned long long)clock64(); \
        ts_lo = (lane == nts) ? (int)(unsigned)_c : ts_lo; ts_hi = (lane == nts) ? (int)(unsigned)(_c >> 32) : ts_hi; ++nts; } } while (0)
    PG8_STAMP();
    unsigned voffA[2], voffB[2];
#pragma unroll
    for (int i = 0; i < 2; ++i) { int R, C; stage_rc(tid * 16 + i * 8192, R, C); const int Rb = Epi::PERM ? ((R & ~31) + perm32(R & 31)) : R;
        voffA[i] = (unsigned)(R * K + C) * 2u; voffB[i] = (unsigned)(Rb * K + C) * 2u; }
    const size_t kstep = (size_t)(BK * 2);
    const size_t hstep = (size_t)HALF * K * 2;
    const size_t tstep = 2 * hstep;
    const unsigned ldsw = (unsigned)wid * 1024u;
    const int aoff = lds_byte(wr * 64 + fr, fq * 8), boff = lds_byte(wc * 32 + fr, fq * 8);
#define PG8_SA(b, h) (((b) * 2 + (h)) * HTB)
#define PG8_SB(b, h) ((4 + (b) * 2 + (h)) * HTB)
#define PG8_STAGE(bufoff, gbase, voff) do { _Pragma("unroll") for (int _i = 0; _i < 2; ++_i) \
        __builtin_amdgcn_global_load_lds((const unsigned*)((const char*)(gbase) + (voff)[_i]), (PG8_LAS unsigned*)(lds + (bufoff) + ldsw + _i * 8192), 16, 0, 0); } while (0)
#define PG8_LDA(dst, b, h) do { _Pragma("unroll") for (int m = 0; m < 4; ++m) _Pragma("unroll") for (int k = 0; k < 2; ++k) dst[m][k] = *(const PG8_LAS bf16x8*)(lds + PG8_SA(b, h) + aoff + m * 2048 + k * 1024); } while (0)
#define PG8_LDB(dst, b, h) do { _Pragma("unroll") for (int n = 0; n < 2; ++n) _Pragma("unroll") for (int k = 0; k < 2; ++k) dst[n][k] = *(const PG8_LAS bf16x8*)(lds + PG8_SB(b, h) + boff + n * 2048 + k * 1024); } while (0)
#define PG8_MMA(ai, bj, At, Bt) do { __builtin_amdgcn_s_setprio(1); _Pragma("unroll") for (int m = 0; m < 4; ++m) _Pragma("unroll") for (int n = 0; n < 2; ++n) _Pragma("unroll") for (int k = 0; k < 2; ++k) \
        acc[ai][bj][m][n] = __builtin_amdgcn_mfma_f32_16x16x32_bf16(Bt[n][k], At[m][k], acc[ai][bj][m][n], 0, 0, 0); __builtin_amdgcn_s_setprio(0); } while (0)
#define PG8_WAIT_V(n) asm volatile("s_waitcnt vmcnt(" #n ")" ::: "memory")
#define PG8_WAIT_L(n) asm volatile("s_waitcnt lgkmcnt(" #n ")" ::: "memory")
#define PG8_BAR __builtin_amdgcn_s_barrier()
#define PG8_SCHED __builtin_amdgcn_sched_barrier(0)
    Unit cur, nxt; int ui = 0;
    if (!S.next(0, cur)) return;
    f32x4 acc[2][2][4][2];
#pragma unroll
    for (int a = 0; a < 2; ++a)
#pragma unroll
        for (int b = 0; b < 2; ++b)
#pragma unroll
            for (int m = 0; m < 4; ++m)
#pragma unroll
                for (int n = 0; n < 2; ++n) acc[a][b][m][n] = (f32x4){0.f, 0.f, 0.f, 0.f};
    bf16x8 At[4][2], B0[2][2], B1[2][2];
    const char* cA = (const char*)g.A + (size_t)cur.pm * tstep; const char* cB = (const char*)g.Bt + (size_t)cur.pn * tstep;
    S.a_ready(cur);
    PG8_STAGE(PG8_SB(0, 0), cB, voffB); PG8_STAGE(PG8_SA(0, 0), cA, voffA); PG8_STAGE(PG8_SB(0, 1), cB + hstep, voffB); PG8_STAGE(PG8_SA(0, 1), cA + hstep, voffA);
    if (wr == 1) PG8_BAR;
    PG8_WAIT_V(4); PG8_BAR;
    PG8_STAGE(PG8_SB(1, 0), cB + kstep, voffB); PG8_STAGE(PG8_SA(1, 0), cA + kstep, voffA); PG8_STAGE(PG8_SB(1, 1), cB + hstep + kstep, voffB);
    PG8_WAIT_V(6); PG8_BAR;
    PG8_STAMP();
    for (;;) {
        const bool has_next = S.next(ui + 1, nxt);
        const char* nA = has_next ? (const char*)g.A + (size_t)nxt.pm * tstep : cA; const char* nB = has_next ? (const char*)g.Bt + (size_t)nxt.pn * tstep : cB;
        for (int t = 0; t < nt; t += 2) {
            const bool last = (t == nt - 2);
            const char* a1 = cA + (size_t)(t + 1) * kstep;
            const char* a2 = last ? nA : cA + (size_t)(t + 2) * kstep; const char* b2 = last ? nB : cB + (size_t)(t + 2) * kstep;
            const char* a3 = a2 + kstep; const char* b3 = b2 + kstep;
            if constexpr (Epi::RESCALE) { if (t == 8 || t == 16) E.rescale(acc, cur, wr, wc, fr, fq, t >> 3); }
            if (last && has_next) S.a_ready(nxt);
            PG8_LDB(B0, 0, 0); PG8_SCHED; PG8_LDA(At, 0, 0); PG8_STAGE(PG8_SA(1, 1), a1 + hstep, voffA);
            PG8_WAIT_L(8); PG8_BAR; PG8_WAIT_L(0); PG8_MMA(0, 0, At, B0); PG8_BAR; PG8_SCHED;
            PG8_LDB(B1, 0, 1); PG8_STAGE(PG8_SB(0, 0), b2, voffB);
            PG8_BAR; PG8_WAIT_L(0); PG8_MMA(0, 1, At, B1); PG8_BAR;
            PG8_LDA(At, 0, 1); PG8_STAGE(PG8_SA(0, 0), a2, voffA);
            PG8_BAR; PG8_WAIT_L(0); PG8_MMA(1, 0, At, B0); PG8_BAR; PG8_SCHED;
            PG8_STAGE(PG8_SB(0, 1), b2 + hstep, voffB);
            PG8_WAIT_V(6); PG8_BAR; PG8_MMA(1, 1, At, B1); PG8_BAR;
            PG8_LDB(B0, 1, 0); PG8_SCHED; PG8_LDA(At, 1, 0); PG8_STAGE(PG8_SA(0, 1), a2 + hstep, voffA);
            PG8_WAIT_L(8); PG8_BAR; PG8_WAIT_L(0); PG8_MMA(0, 0, At, B0); PG8_BAR; PG8_SCHED;
            PG8_LDB(B1, 1, 1); PG8_STAGE(PG8_SB(1, 0), b3, voffB);
            PG8_BAR; PG8_WAIT_L(0); PG8_MMA(0, 1, At, B1); PG8_BAR;
            PG8_LDA(At, 1, 1); PG8_STAGE(PG8_SA(1, 0), a3, voffA);
            PG8_BAR; PG8_WAIT_L(0); PG8_MMA(1, 0, At, B0); PG8_BAR; PG8_SCHED;
            PG8_STAGE(PG8_SB(1, 1), b3 + hstep, voffB);
            PG8_WAIT_V(6); PG8_BAR; PG8_MMA(1, 1, At, B1); PG8_BAR;
        }
        PG8_STAMP();
        if constexpr (!Epi::AFTER_DRAIN) { E(acc, cur, wr, wc, fr, fq); S.done(cur); }
        PG8_STAMP();
        if (!has_next) break;
#pragma unroll
        for (int a = 0; a < 2; ++a)
#pragma unroll
            for (int b = 0; b < 2; ++b)
#pragma unroll
                for (int m = 0; m < 4; ++m)
#pragma unroll
                    for (int n = 0; n < 2; ++n) acc[a][b][m][n] = (f32x4){0.f, 0.f, 0.f, 0.f};
        cur = nxt; cA = nA; cB = nB; ++ui;
    }
    PG8_WAIT_V(0);
    if (wr == 0) PG8_BAR;
    PG8_BAR;
    if constexpr (Epi::AFTER_DRAIN) { E.fused(acc, cur, wr, wc, fr, fq, lds, wid, lane); S.done(cur); }
    PG8_STAMP();
    if (STAMP && wid == 0) { stamps[lane] = lane < nts ? (((unsigned long long)(unsigned)ts_hi << 32) | (unsigned)ts_lo) : 0ull;
        if (lane == 62) stamps[62] = rt_entry; if (lane == 63) stamps[63] = (unsigned long long)wall_clock64(); }
#undef PG8_STAMP
#undef PG8_SA
#undef PG8_SB
#undef PG8_STAGE
#undef PG8_LDA
#undef PG8_LDB
#undef PG8_MMA
#undef PG8_WAIT_V
#undef PG8_WAIT_L
#undef PG8_BAR
#undef PG8_SCHED
}
}


__device__ __forceinline__ void gemm_loop(const u16* __restrict__ A, long lda, const u16* __restrict__ W, long ldw,
                                          int K, char* smem, f32x4 (&acc)[4][4]) {
  const int t = TID(), lane = t & 63, w = t >> 6, wm = w & 3, wn = w >> 2;
  const int lr = t >> 3, kc = (t & 7) * 8;
  u16* sA = (u16*)smem;
  u16* sW = sA + 256 * 72;
  const u16* ga = A + (long)lr * lda + kc;
  const u16* gw = W + (long)lr * ldw + kc;
  u32x4 ra[4], rw[2];
#pragma unroll
  for (int i = 0; i < 4; ++i) ra[i] = *(const u32x4*)(ga + (long)(64 * i) * lda);
#pragma unroll
  for (int i = 0; i < 2; ++i) rw[i] = *(const u32x4*)(gw + (long)(64 * i) * ldw);
  const int fr = lane & 15, fq = (lane >> 4) * 8;
  for (int k0 = 0; k0 < K; k0 += 64) {
    __syncthreads();
#pragma unroll
    for (int i = 0; i < 4; ++i) *(u32x4*)(sA + (lr + 64 * i) * 72 + kc) = ra[i];
#pragma unroll
    for (int i = 0; i < 2; ++i) *(u32x4*)(sW + (lr + 64 * i) * 72 + kc) = rw[i];
    __syncthreads();
    if (k0 + 64 < K) {
#pragma unroll
      for (int i = 0; i < 4; ++i) ra[i] = *(const u32x4*)(ga + (long)(64 * i) * lda + k0 + 64);
#pragma unroll
      for (int i = 0; i < 2; ++i) rw[i] = *(const u32x4*)(gw + (long)(64 * i) * ldw + k0 + 64);
    }
#pragma unroll
    for (int ks = 0; ks < 2; ++ks) {
      bf16x8 fa[4], fw[4];
#pragma unroll
      for (int i = 0; i < 4; ++i) fw[i] = ldfrag(sW, wn * 64 + i * 16 + fr, 72, ks * 32 + fq);
#pragma unroll
      for (int j = 0; j < 4; ++j) fa[j] = ldfrag(sA, wm * 64 + j * 16 + fr, 72, ks * 32 + fq);
#pragma unroll
      for (int i = 0; i < 4; ++i)
#pragma unroll
        for (int j = 0; j < 4; ++j) acc[i][j] = MFMA(fw[i], fa[j], acc[i][j]);
    }
  }
}
__device__ __forceinline__ void zero_acc(f32x4 (&acc)[4][4]) {
#pragma unroll
  for (int i = 0; i < 4; ++i)
#pragma unroll
    for (int j = 0; j < 4; ++j) acc[i][j] = f32x4{0.f, 0.f, 0.f, 0.f};
}
#define EPI_LOOP(...)                                                         \
  {                                                                           \
    const int _t = TID(), _lane = _t & 63, _w = _t >> 6;                \
    const int _wm = _w & 3, _wn = _w >> 2;                                    \
    _Pragma("unroll") for (int _i = 0; _i < 4; ++_i)                          \
    _Pragma("unroll") for (int _j = 0; _j < 4; ++_j) {                        \
      const int ml = _wm * 64 + _j * 16 + (_lane & 15);                       \
      const int nl = _wn * 64 + _i * 16 + (_lane >> 4) * 4;                   \
      f32x4 v = acc[_i][_j];                                                  \
      __VA_ARGS__                                                             \
    }                                                                         \
  }

__device__ __forceinline__ int mod_idx(int r) { return r < MLAT ? (r >> 12) : 8; }

struct S5c { float lr, li, dt; };
__device__ __forceinline__ S5c s5_load(const P& p, int l, int dir, int g, int s) {
  S5c c;
  float lre = lptr(p.in[14])[((l * 2 + dir) * 32 + g) * 64 + s];
  c.lr = fminf(lre, -1e-4f);
  c.li = lptr(p.in[15])[((l * 2 + dir) * 32 + g) * 64 + s];
  c.dt = expf(lptr(p.in[16])[(l * 2 + dir) * 32 + g]);
  return c;
}
__device__ __forceinline__ void s5_pow(const S5c& c, int j, float& re, float& im) {
  float mag = expf(c.lr * c.dt * (float)j);
  float th = c.li * c.dt;
  th -= 6.283185307179586f * rintf(th * 0.15915494309189535f);
  float ang = th * (float)j;
  float sn, cs;
  sincosf(ang, &sn, &cs);
  re = mag * cs;
  im = mag * sn;
}
__device__ __forceinline__ void s5_coef(const S5c& c, float& cr, float& ci) {
  float ar, ai;
  s5_pow(c, 1, ar, ai);
  float den = c.lr * c.lr + c.li * c.li;
  cr = ((ar - 1.0f) * c.lr + ai * c.li) / den;
  ci = (ai * c.lr - (ar - 1.0f) * c.li) / den;
}


__device__ __forceinline__ void ph_init(const P& p, int item, char* smem) {
  const int t = TID();
  if (item < 192) {
    const int l = item / 96, nb = item % 96;
    float* sc = (float*)smem;
    float* part = sc + 9 * 1024;
    __syncthreads();
    for (int e = t; e < 9 * 1024; e += NT) {
      int r = e >> 10, k = e & 1023;
      float cv = r < 8 ? lptr(p.in[1])[r * 1024 + k] : lptr(p.in[3])[k];
      sc[e] = siluf(cv);
    }
    __syncthreads();
    const int col = t & 63, kg = t >> 6;
    const float* wp = lptr(p.in[4]) + (size_t)l * 1024 * 6144 + nb * 64 + col;
    float a[9];
#pragma unroll
    for (int r = 0; r < 9; ++r) a[r] = 0.f;
    for (int k = kg * 128; k < kg * 128 + 128; ++k) {
      float wv = wp[(size_t)k * 6144];
#pragma unroll
      for (int r = 0; r < 9; ++r) a[r] += sc[r * 1024 + k] * wv;
    }
#pragma unroll
    for (int r = 0; r < 9; ++r) part[(kg * 9 + r) * 64 + col] = a[r];
    __syncthreads();
    float* mods = (float*)(lptr(p.ws) + OFF_MODS);
    for (int e = t; e < 9 * 64; e += NT) {
      int r = e >> 6, c2 = e & 63;
      float s = 0.f;
      for (int g2 = 0; g2 < 8; ++g2) s += part[(g2 * 9 + r) * 64 + c2];
      int n = nb * 64 + c2;
      mods[(l * 9 + r) * 6144 + n] = s + lptr(p.in[5])[l * 6144 + n];
    }
  } else if (item < 448) {
    const int it = item - 192;
    const float4* src = (const float4*)lptr(p.in[2]);
    float4* dst = (float4*)(lptr(p.ws) + OFF_XC);
#pragma unroll
    for (int i = 0; i < 4; ++i) dst[(size_t)it * 2048 + i * 512 + t] = src[(size_t)it * 2048 + i * 512 + t];
  } else {
    float* lb = (float*)(lptr(p.ws) + OFF_LB);
    for (int e = t; e < 1024; e += NT) {
      float l0 = lptr(p.in[8])[e], l1 = lptr(p.in[8])[1024 + e];
      float m = fmaxf(l0, l1);
      float e0 = expf(l0 - m), e1 = expf(l1 - m);
      lb[e] = 0.f;
      lb[1024 + e] = e1 / (e0 + e1);
    }
  }
}

__device__ __forceinline__ void transpose_tile(const float* __restrict__ src, int Nsrc, u16* __restrict__ dst, int K, int tn, int tk4,
                               bool win_map, char* smem, int ldd = 0, int koff = 0) {
  if (ldd == 0) ldd = K;
  float* tile = (float*)smem;
  const int t = TID(), tx = t & 63, ty = t >> 6;
  __syncthreads();
  int np = tn * 64 + tx;
  int sc = np;
  bool zero = false;
  if (win_map) {
    if (np >= 4864) sc = np - 240;
    else if (np >= 4624) zero = true;
  }
  float v[32];
#pragma unroll
  for (int i = 0; i < 32; ++i) {
    int kk = ty + 8 * i;
    v[i] = zero ? 0.f : src[(size_t)(tk4 * 256 + kk) * Nsrc + sc];
  }
#pragma unroll
  for (int i = 0; i < 32; ++i) tile[tx * 257 + ty + 8 * i] = v[i];
  __syncthreads();
#pragma unroll
  for (int i = 0; i < 8; ++i) {
    int nn = ty + 8 * i;
#pragma unroll
    for (int j = 0; j < 2; ++j) {
      int kk = 2 * tx + 128 * j;
      *(unsigned*)(dst + (size_t)(tn * 64 + nn) * ldd + koff + tk4 * 256 + kk) = pack2(tile[nn * 257 + kk], tile[nn * 257 + kk + 1]);
    }
  }
}

__device__ __forceinline__ void norm_rows(const P& p, int l, int item, int which) {
  const int t = TID(), lane = t & 63, w = t >> 6;
  const float* nw = (which == 0 ? lptr(p.in[6]) : lptr(p.in[27])) + l * 1024;
  float4 v[2][4];
  float ss[2];
#pragma unroll
  for (int q = 0; q < 2; ++q) {
    const int r = item * 16 + w * 2 + q;
    const float* xr;
    if (r < MLAT) xr = ((which == 0 && l == 0) ? lptr(p.in[0]) : lptr(p.out)) + (size_t)r * 1024;
    else xr = (const float*)(lptr(p.ws) + OFF_XC) + (size_t)(r - MLAT) * 1024;
#pragma unroll
    for (int i = 0; i < 4; ++i) v[q][i] = *(const float4*)(xr + i * 256 + lane * 4);
  }
#pragma unroll
  for (int q = 0; q < 2; ++q) {
    float a = 0.f;
#pragma unroll
    for (int i = 0; i < 4; ++i) a += v[q][i].x * v[q][i].x + v[q][i].y * v[q][i].y + v[q][i].z * v[q][i].z + v[q][i].w * v[q][i].w;
    ss[q] = wsum(a);
  }
#pragma unroll
  for (int q = 0; q < 2; ++q) {
    const int r = item * 16 + w * 2 + q;
    const float* mods = (const float*)(lptr(p.ws) + OFF_MODS) + (size_t)(l * 9 + mod_idx(r)) * 6144;
    const float* sh = mods + (which == 0 ? 0 : 3) * 1024;
    const float* scl = mods + (which == 0 ? 1 : 4) * 1024;
    float rstd = rsqrtf(ss[q] * (1.f / 1024.f) + 1e-6f);
    u16* H = (u16*)(lptr(p.ws) + OFF_H) + (size_t)r * 1024;
#pragma unroll
    for (int i = 0; i < 4; ++i) {
      int c = i * 256 + lane * 4;
      float4 wv = *(const float4*)(nw + c), s1 = *(const float4*)(sh + c), s2 = *(const float4*)(scl + c);
      f32x4 o;
      o[0] = v[q][i].x * rstd * wv.x * (1.f + s2.x) + s1.x;
      o[1] = v[q][i].y * rstd * wv.y * (1.f + s2.y) + s1.y;
      o[2] = v[q][i].z * rstd * wv.z * (1.f + s2.z) + s1.z;
      o[3] = v[q][i].w * rstd * wv.w * (1.f + s2.w) + s1.w;
      *(uint2*)(H + c) = pack4(o);
    }
  }
}

__device__ __forceinline__ void s5_ktable(const P& p, int l, int item, char* smem) {
  const int t = TID();
  const int jb = item & 7, g = (item >> 3) & 31, dir = item >> 8;
  float2* pwB = (float2*)smem;
  float2* Cc = pwB + 8192;
  float2* pc = Cc + 1024;
  __syncthreads();
  {
    int s0 = t & 63, jj = t >> 6;
    S5c c = s5_load(p, l, dir, g, s0);
    float pr, pi, cr, ci;
    s5_pow(c, jb * 8 + jj, pr, pi);
    s5_coef(c, cr, ci);
    pc[t] = float2{pr * cr - pi * ci, pr * ci + pi * cr};
  }
#pragma unroll 1
  for (int e = t; e < 1024; e += NT) {
    int co = e >> 6, s2 = e & 63;
    Cc[e] = float2{lptr(p.in[19])[((size_t)(l * 32 + g) * 16 + co) * 64 + s2], lptr(p.in[20])[((size_t)(l * 32 + g) * 16 + co) * 64 + s2]};
  }
  __syncthreads();
#pragma unroll 1
  for (int e = t; e < 1024; e += NT) {
    int s = e >> 4;
    float br = lptr(p.in[17])[((size_t)(l * 32 + g) * 64) * 16 + e];
    float bi = lptr(p.in[18])[((size_t)(l * 32 + g) * 64) * 16 + e];
#pragma unroll
    for (int jj = 0; jj < 8; ++jj) {
      float2 q = pc[jj * 64 + s];
      pwB[jj * 1024 + e] = float2{q.x * br - q.y * bi, q.x * bi + q.y * br};
    }
  }
  __syncthreads();
  float* KT = (float*)(lptr(p.ws) + OFF_KT);
#pragma unroll 1
  for (int o = t; o < 2048; o += NT) {
    int jj = o >> 8, cc = o & 255, co = cc >> 4, ci2 = cc & 15;
    float acc = 0.f;
#pragma unroll 8
    for (int s = 0; s < 64; ++s) {
      float2 c = Cc[co * 64 + s], b = pwB[jj * 1024 + s * 16 + ci2];
      acc += c.x * b.x - c.y * b.y;
    }
    KT[((size_t)((dir * 32 + g) * 64 + jb * 8 + jj)) * 256 + cc] = acc;
  }
}

__device__ __forceinline__ void ph_start(const P& p, int l, int item, char* smem) {
  u16* WT = (u16*)(lptr(p.ws) + OFF_WT);
  if (item < 1216) {
    int it = item;
    if (it < 528) { transpose_tile(lptr(p.in[7]) + (size_t)l * 1024 * 8208, 8208, WT + W_IN, 1024, it >> 2, it & 3, true, smem); return; }
    it -= 528;
    if (it < 256) { transpose_tile(lptr(p.in[28]) + (size_t)l * 1024 * 4096, 4096, WT + W_FF1, 1024, it >> 2, it & 3, false, smem); return; }
    it -= 256;
    if (it < 256) { transpose_tile(lptr(p.in[29]) + (size_t)l * 4096 * 1024, 1024, WT + W_FF2, 4096, it >> 4, it & 15, false, smem); return; }
    it -= 256;
    if (it < 64) { transpose_tile(lptr(p.in[26]) + (size_t)l * 1024 * 1024, 1024, WT + W_O, 1024, it >> 2, it & 3, false, smem); return; }
    it -= 64;
    if (it < 96) {
      int which = it >> 5, ii = it & 31;
      const float* src = lptr(p.in[23 + which]) + (size_t)l * 512 * 1024;
      transpose_tile(src, 1024, WT + W_BA, 512, ii >> 1, ii & 1, false, smem, 1536, which * 512);
      return;
    }
    it -= 96;
    transpose_tile(lptr(p.in[22]) + (size_t)l * 512 * 512, 512, WT + W_GLU, 512, it >> 1, it & 1, false, smem);
    return;
  }
  item -= 1216;
  if (item < 2176) { norm_rows(p, l, item, 0); return; }
  item -= 2176;
  s5_ktable(p, l, item, smem);
}

__device__ __forceinline__ void prep_a(const P& p, int l, char* smem) {
  const int t = TID(), lane = t & 63, w = t >> 6;
  u16* qh = (u16*)smem;
  u16* kh = qh + 64 * 136;
  u16* ktl = kh + 64 * 136;
  u16* vT = ktl + 128 * 72;
  u16* at = vT + 128 * 72;
  float* tot = (float*)(at + 64 * 72);
  float* c31 = tot + 512;
  float* lst = c31 + 128;
  u16* PA = (u16*)(lptr(p.ws) + OFF_R + R_PA);
  u16* NX = (u16*)(lptr(p.ws) + OFF_NA);
  float* EL = (float*)(lptr(p.ws) + OFF_BA);
  const int d = t & 127, qtr = t >> 7;
  const int fr = lane & 15, fq = lane >> 4;
  u16 zr[16], qr[16];
  u32x4 pv0, pv1;
#define ISSUE_P(jj)                                                                             \
  {                                                                                             \
    const int it_ = (int)blockIdx.x + ((jj) >> 1) * (int)gridDim.x, dir_ = (jj) & 1;            \
    const int cn_ = it_ % 68, h_ = (it_ / 68) & 3, b_ = it_ / 272;                              \
    const int cs_ = dir_ == 0 ? cn_ : (cn_ < 4 ? 3 - cn_ : 71 - cn_);                           \
    _Pragma("unroll") for (int i = 0; i < 16; ++i) {                                            \
      int row_ = chain_row(b_, dir_, cs_, qtr * 16 + i);                                        \
      const u16* pr_ = PA + (size_t)row_ * 2560;                                                \
      zr[i] = pr_[1024 + dir_ * 512 + h_ * 128 + d];                                            \
      qr[i] = pr_[h_ * 128 + d];                                                                \
    }                                                                                           \
    int rowv_ = chain_row(b_, dir_, cs_, t >> 3);                                               \
    const u32x4* vp_ = (const u32x4*)(PA + (size_t)rowv_ * 2560 + 512 + h_ * 128 + (t & 7) * 16); \
    pv0 = vp_[0]; pv1 = vp_[1];                                                                 \
  }
  const int nj = ((2176 - (int)blockIdx.x + (int)gridDim.x - 1) / (int)gridDim.x) * 2;
  if (nj > 0) ISSUE_P(0)
#pragma unroll 1
  for (int j = 0; j < nj; ++j) {
    const int item = (int)blockIdx.x + (j >> 1) * (int)gridDim.x, dir = j & 1;
    const int cnat = item % 68, h = (item / 68) & 3, b = item / 272;
    const int rbase = cnat < 4 ? MLAT + b * 256 + cnat * 64 : b * 4096 + (cnat - 4) * 64;
    const int cstep = dir == 0 ? cnat : (cnat < 4 ? 3 - cnat : 71 - cnat);
    const float lbv = ((const float*)(lptr(p.ws) + OFF_LB))[(l * 2 + dir) * 512 + h * 128 + d];
    u16* OUT = (u16*)(lptr(p.ws) + OFF_R + (dir == 0 ? R_OF : R_OB));
    float cum[16], qv[16], kv[16];
    LDS_SYNC();
    {
      float run = 0.f;
#pragma unroll
      for (int i = 0; i < 16; ++i) {
        float z = bf2f(zr[i]);
        float f = lbv + (1.f - lbv) * sigm(z);
        run += __logf(f);
        cum[i] = run;
        kv[i] = 1.f - f;
        qv[i] = siluf(bf2f(qr[i]));
      }
      tot[qtr * 128 + d] = run;
    }
    {
      int sg = t >> 3, v0 = (t & 7) * 16;
      u32x4 a0 = pv0, a1 = pv1;
#pragma unroll
      for (int i = 0; i < 4; ++i) {
        vT[(v0 + 2 * i) * 72 + sg] = (u16)(a0[i] & 0xffff);
        vT[(v0 + 2 * i + 1) * 72 + sg] = (u16)(a0[i] >> 16);
        vT[(v0 + 8 + 2 * i) * 72 + sg] = (u16)(a1[i] & 0xffff);
        vT[(v0 + 8 + 2 * i + 1) * 72 + sg] = (u16)(a1[i] >> 16);
      }
    }
    if (j + 1 < nj) ISSUE_P(j + 1)
    LDS_SYNC();
    {
      float off = 0.f;
      for (int q2 = 0; q2 < qtr; ++q2) off += tot[q2 * 128 + d];
#pragma unroll
      for (int i = 0; i < 16; ++i) cum[i] += off;
      if (qtr == 1) c31[d] = cum[15];
      if (qtr == 3) lst[d] = cum[15];
    }
    LDS_SYNC();
    {
      float cm = c31[d], la = lst[d];
      float ecm = __expf(cm), elc = __expf(la - cm);
      if (qtr == 3) EL[((size_t)(((dir * 8 + b) * 4 + h) * 68 + cstep)) * 128 + d] = __expf(la);
#pragma unroll
      for (int i = 0; i < 16; ++i) {
        int tau = qtr * 16 + i;
        float qhat = qv[i] * __expf(cum[i] - cm);
        float khat = kv[i] * __expf(cm - cum[i]);
        qh[tau * 136 + d] = f2bf(qhat);
        kh[tau * 136 + d] = f2bf(khat);
        ktl[d * 72 + tau] = f2bf(khat * elc);
        int row = chain_row(b, dir, cstep, tau);
        PA[(size_t)row * 2560 + 1024 + dir * 512 + h * 128 + d] = f2bf(qhat * ecm);
      }
    }
    LDS_SYNC();
    {
      int dd = t >> 2, s0 = (t & 3) * 16;
      u32x4 a0 = *(const u32x4*)(ktl + dd * 72 + s0), a1 = *(const u32x4*)(ktl + dd * 72 + s0 + 8);
      u16* dst = NX + (size_t)(rbase + (t >> 3)) * 1536 + 512 + dir * 512 + h * 128 + (t & 7) * 16;
      *(u32x4*)dst = a0;
      *(u32x4*)(dst + 8) = a1;
    }
    {
      int tt = w >> 1;
#pragma unroll
      for (int u = 0; u < 2; ++u) {
        int st = (w & 1) * 2 + u;
        f32x4 a = f32x4{0.f, 0.f, 0.f, 0.f};
        if (st <= tt) {
#pragma unroll
          for (int ks = 0; ks < 4; ++ks)
            a = MFMA(ldfrag(kh, st * 16 + fr, 136, ks * 32 + fq * 8), ldfrag(qh, tt * 16 + fr, 136, ks * 32 + fq * 8), a);
          int tau = tt * 16 + fr;
#pragma unroll
          for (int r = 0; r < 4; ++r) {
            int sg = st * 16 + fq * 4 + r;
            if (sg > tau) a[r] = 0.f;
          }
        }
        *(uint2*)(at + (tt * 16 + fr) * 72 + st * 16 + fq * 4) = pack4(a);
      }
    }
    LDS_SYNC();
    {
      int tt = w >> 1;
      int row = chain_row(b, dir, cstep, tt * 16 + fr);
#pragma unroll
      for (int u = 0; u < 4; ++u) {
        int vt = (w & 1) * 4 + u;
        f32x4 a = f32x4{0.f, 0.f, 0.f, 0.f};
#pragma unroll
        for (int ks = 0; ks < 2; ++ks)
          a = MFMA(ldfrag(vT, vt * 16 + fr, 72, ks * 32 + fq * 8), ldfrag(at, tt * 16 + fr, 72, ks * 32 + fq * 8), a);
        *(uint2*)(OUT + (size_t)row * 512 + h * 128 + vt * 16 + fq * 4) = pack4(a);
      }
    }
  }
}
#undef ISSUE_P

__device__ __forceinline__ void chain_a(const P& p, int l, int item, char* smem) {
  const int t = TID(), lane = t & 63, w = t >> 6;
  const int vs = (item >> 3) & 3, chn = ((item >> 5) << 3) | (item & 7), dir = chn & 1, h = (chn >> 1) & 3, b = chn >> 3;
  u16* qh = (u16*)smem;
  u16* khT = qh + 64 * 136;
  u16* vT = khT + 128 * 72;
  u16* sT = vT + 32 * 72;
  float* lst = (float*)(sT + 32 * 136);
  const u16* PA = (const u16*)(lptr(p.ws) + OFF_R + R_PA);
  const u16* NX = (const u16*)(lptr(p.ws) + OFF_NA);
  const float* EL = (const float*)(lptr(p.ws) + OFF_BA);
  u16* OUT = (u16*)(lptr(p.ws) + OFF_R + (dir == 0 ? R_OF : R_OB));
  const int fr = lane & 15, fq = lane >> 4;
  const int vt = w & 1, tt = w >> 1;
  f32x4 S[2];
  S[0] = f32x4{0.f, 0.f, 0.f, 0.f};
  S[1] = S[0];
  u32x4 pq0, pq1, pk0, pk1;
  unsigned pv0, pv1, po0, po1;
  float pel = 0.f;
#define ISSUE_A(cc)                                                                               \
  {                                                                                               \
    int row = chain_row(b, dir, (cc), t >> 3);                                                    \
    const u16* sq = PA + (size_t)row * 2560 + 1024 + dir * 512 + h * 128 + (t & 7) * 16;          \
    pq0 = *(const u32x4*)sq; pq1 = *(const u32x4*)(sq + 8);                                       \
    const unsigned* vp = (const unsigned*)(PA + (size_t)row * 2560 + 512 + h * 128 + vs * 32 + (t & 7) * 4); \
    pv0 = vp[0]; pv1 = vp[1];                                                                     \
    int cn = dir == 0 ? (cc) : ((cc) < 4 ? 3 - (cc) : 71 - (cc));                                 \
    int rb = cn < 4 ? MLAT + b * 256 + cn * 64 : b * 4096 + (cn - 4) * 64;                        \
    const u16* sk = NX + (size_t)(rb + (t >> 3)) * 1536 + 512 + dir * 512 + h * 128 + (t & 7) * 16; \
    pk0 = *(const u32x4*)sk; pk1 = *(const u32x4*)(sk + 8);                                       \
    int orow = chain_row(b, dir, (cc), tt * 16 + fr);                                             \
    const unsigned* op = (const unsigned*)(OUT + (size_t)orow * 512 + h * 128 + vs * 32 + vt * 16 + fq * 4); \
    po0 = op[0]; po1 = op[1];                                                                     \
    if (t < 128) pel = EL[((size_t)(((dir * 8 + b) * 4 + h) * 68 + (cc))) * 128 + t];             \
  }
  ISSUE_A(0)
  for (int c = 0; c < 68; ++c) {
    LDS_SYNC();
    {
      int tau = t >> 3, d0 = (t & 7) * 16;
      *(u32x4*)(qh + tau * 136 + d0) = pq0;
      *(u32x4*)(qh + tau * 136 + d0 + 8) = pq1;
      int dd = t >> 2, s0 = (t & 3) * 16;
      *(u32x4*)(khT + dd * 72 + s0) = pk0;
      *(u32x4*)(khT + dd * 72 + s0 + 8) = pk1;
      int v4 = (t & 7) * 4;
      vT[(v4 + 0) * 72 + tau] = (u16)(pv0 & 0xffff);
      vT[(v4 + 1) * 72 + tau] = (u16)(pv0 >> 16);
      vT[(v4 + 2) * 72 + tau] = (u16)(pv1 & 0xffff);
      vT[(v4 + 3) * 72 + tau] = (u16)(pv1 >> 16);
      if (t < 128) lst[t] = pel;
#pragma unroll
      for (int v2 = 0; v2 < 2; ++v2) *(uint2*)(sT + (v2 * 16 + fr) * 136 + w * 16 + fq * 4) = pack4(S[v2]);
    }
    const unsigned oi0 = po0, oi1 = po1;
    const int crow = chain_row(b, dir, c, tt * 16 + fr);
    LDS_SYNC();
    if (c + 1 < 68) ISSUE_A(c + 1)
    {
      f32x4 a = f32x4{0.f, 0.f, 0.f, 0.f};
#pragma unroll
      for (int ks = 0; ks < 4; ++ks)
        a = MFMA(ldfrag(sT, vt * 16 + fr, 136, ks * 32 + fq * 8), ldfrag(qh, tt * 16 + fr, 136, ks * 32 + fq * 8), a);
      a[0] += bf2f((u16)(oi0 & 0xffff));
      a[1] += bf2f((u16)(oi0 >> 16));
      a[2] += bf2f((u16)(oi1 & 0xffff));
      a[3] += bf2f((u16)(oi1 >> 16));
      *(uint2*)(OUT + (size_t)crow * 512 + h * 128 + vs * 32 + vt * 16 + fq * 4) = pack4(a);
#pragma unroll
      for (int v2 = 0; v2 < 2; ++v2) {
        f32x4 ds = f32x4{0.f, 0.f, 0.f, 0.f};
#pragma unroll
        for (int ks = 0; ks < 2; ++ks)
          ds = MFMA(ldfrag(khT, w * 16 + fr, 72, ks * 32 + fq * 8), ldfrag(vT, v2 * 16 + fr, 72, ks * 32 + fq * 8), ds);
#pragma unroll
        for (int r = 0; r < 4; ++r) S[v2][r] = lst[w * 16 + fq * 4 + r] * S[v2][r] + ds[r];
      }
    }
  }
}
#undef ISSUE_A

__device__ __forceinline__ void normgate(const P& p, int l, int item, int which) {
  const int t = TID(), lane = t & 63, w = t >> 6;
  const int row0 = item * 16 + w * 2;
  char* R = lptr(p.ws) + OFF_R;
  const u16 *ofb, *obb, *gtb;
  int so, sg;
  const float* nw;
  u16* outb;
  if (which == 0) {
    ofb = (const u16*)(R + R_OF); obb = (const u16*)(R + R_OB); so = 512;
    gtb = (const u16*)(R + R_PA) + 2048; sg = 2560;
    nw = lptr(p.in[9]) + l * 128;
    outb = (u16*)(lptr(p.ws) + OFF_NA);
  } else {
    ofb = (const u16*)(R + R_PB) + 512; obb = (const u16*)(R + R_PB) + 1024; so = 2304;
    gtb = (const u16*)(R + R_PB) + 1536; sg = 2304;
    nw = lptr(p.in[13]) + l * 128;
    outb = (u16*)(lptr(p.ws) + OFF_NA) + 512;
  }
  unsigned a[2][4], bb[2][4], g[2][4];
#pragma unroll
  for (int r = 0; r < 2; ++r)
#pragma unroll
    for (int h = 0; h < 4; ++h) {
      int c = h * 128 + lane * 2;
      a[r][h] = *(const unsigned*)(ofb + (size_t)(row0 + r) * so + c);
      bb[r][h] = *(const unsigned*)(obb + (size_t)(row0 + r) * so + c);
      g[r][h] = *(const unsigned*)(gtb + (size_t)(row0 + r) * sg + c);
    }
  const float w0 = nw[lane * 2], w1 = nw[lane * 2 + 1];
#pragma unroll
  for (int r = 0; r < 2; ++r)
#pragma unroll
    for (int h = 0; h < 4; ++h) {
      float o0 = bf2f((u16)(a[r][h] & 0xffff)) + bf2f((u16)(bb[r][h] & 0xffff));
      float o1 = bf2f((u16)(a[r][h] >> 16)) + bf2f((u16)(bb[r][h] >> 16));
      float ss = wsum(o0 * o0 + o1 * o1);
      float rstd = rsqrtf(ss * (1.f / 128.f) + 1e-6f);
      float g0 = bf2f((u16)(g[r][h] & 0xffff)), g1 = bf2f((u16)(g[r][h] >> 16));
      *(unsigned*)(outb + (size_t)(row0 + r) * 1536 + h * 128 + lane * 2) = pack2(o0 * rstd * w0 * siluf(g0), o1 * rstd * w1 * siluf(g1));
    }
}

__device__ __forceinline__ void conv_b(const P& p, int l, int item) {
  const int t = TID(), lane = t & 63, w = t >> 6;
  const int u = item * 8 + w;
  const int tile = u / 12, slot = u % 12;
  const u16* PB = (const u16*)(lptr(p.ws) + OFF_R + R_PB);
  u16* Q = (u16*)(lptr(p.ws) + OFF_R + R_QKV);
  const int row0 = tile * 16;
  int pos0, len;
  if (row0 < MLAT) { pos0 = row0 & 4095; len = 4096; }
  else { pos0 = (row0 - MLAT) & 255; len = 256; }
  const int ch = slot * 128 + lane * 2;
  const float* cw = lptr(p.in[10]) + (size_t)l * 5 * 1536;
  float w0[5], w1[5];
#pragma unroll
  for (int j = 0; j < 5; ++j) { w0[j] = cw[j * 1536 + ch]; w1[j] = cw[j * 1536 + ch + 1]; }
  unsigned raw[20];
#pragma unroll
  for (int i = 0; i < 20; ++i) {
    int pp = pos0 + i - 2;
    raw[i] = (pp >= 0 && pp < len) ? *(const unsigned*)(PB + (size_t)(row0 + i - 2) * 2304 + ch) : 0u;
  }
#pragma unroll
  for (int i = 0; i < 16; ++i) {
    float a0 = 0.f, a1 = 0.f;
#pragma unroll
    for (int j = 0; j < 5; ++j) {
      a0 += w0[j] * bf2f((u16)(raw[i + j] & 0xffff));
      a1 += w1[j] * bf2f((u16)(raw[i + j] >> 16));
    }
    a0 = siluf(a0);
    a1 = siluf(a1);
    if (slot < 8) {
      float ss = wsum(a0 * a0 + a1 * a1);
      float sc = rsqrtf(ss + 1e-6f);
      if (slot < 4) sc *= 0.08838834764831845f;
      a0 *= sc;
      a1 *= sc;
    }
    *(unsigned*)(Q + (size_t)(row0 + i) * 1536 + ch) = pack2(a0, a1);
  }
}

__device__ __forceinline__ void gdn_bg(const P& p, int l, int row, int dir, int h, float& beta, float& g) {
  const float* BA = (const float*)(lptr(p.ws) + OFF_BA) + (size_t)row * 16;
  beta = sigm(BA[dir * 4 + h]);
  float a = BA[8 + dir * 4 + h] + lptr(p.in[12])[(l * 2 + dir) * 4 + h];
  float sp = a > 20.f ? a : log1pf(expf(a));
  g = -expf(lptr(p.in[11])[(l * 2 + dir) * 4 + h]) * sp;
}

__device__ __forceinline__ void tphase_b(const P& p, int l, char* smem) {
  const int t = TID(), lane = t & 63, w = t >> 6;
  u16* ks = (u16*)smem;
  float* Am = (float*)(ks + 64 * 136);
  float* Tm = Am + 64 * 68;
  float* Wm = Tm + 64 * 68;
  float* cumL = Wm + 16 * 68;
  float* betL = cumL + 64;
  const u16* Q = (const u16*)(lptr(p.ws) + OFF_R + R_QKV);
  u16* PB = (u16*)(lptr(p.ws) + OFF_R + R_PB);
  float* BAw = (float*)(lptr(p.ws) + OFF_BA);
  u32x4 pa0, pa1;
  float pbeta = 0.f, pav = 0.f;
#define ISSUE_T(it)                                                                          \
  {                                                                                          \
    const int c_ = (it) % 68, rest_ = (it) / 68;                                             \
    const int dir_ = rest_ & 1, h_ = (rest_ >> 1) & 3, b_ = rest_ >> 3;                      \
    int row_ = chain_row(b_, dir_, c_, t >> 3);                                              \
    const u16* src_ = Q + (size_t)row_ * 1536 + 512 + h_ * 128 + (t & 7) * 16;               \
    pa0 = *(const u32x4*)src_; pa1 = *(const u32x4*)(src_ + 8);                              \
    if (t < 64) {                                                                            \
      int rowt_ = chain_row(b_, dir_, c_, t);                                                \
      pbeta = BAw[(size_t)rowt_ * 16 + dir_ * 4 + h_];                                       \
      pav = BAw[(size_t)rowt_ * 16 + 8 + dir_ * 4 + h_];                                     \
    }                                                                                        \
  }
  int item = blockIdx.x;
  if (item < 4352) ISSUE_T(item)
#pragma unroll 1
  for (; item < 4352; item += gridDim.x) {
  const int c = item % 68;
  const int rest = item / 68;
  const int dir = rest & 1, h = (rest >> 1) & 3, b = rest >> 3;
  LDS_SYNC();
  {
    int tau = t >> 3, d0 = (t & 7) * 16;
    *(u32x4*)(ks + tau * 136 + d0) = pa0;
    *(u32x4*)(ks + tau * 136 + d0 + 8) = pa1;
  }
  for (int e = t; e < 64 * 68; e += NT) Tm[e] = 0.f;
  if (t < 64) {
    int row = chain_row(b, dir, c, t);
    float beta = sigm(pbeta);
    float av = pav + lptr(p.in[12])[(l * 2 + dir) * 4 + h];
    float ex = __expf(av);
    float sp = av > 20.f ? av : (ex < 1e-3f ? ex * (1.f - 0.5f * ex) : __logf(1.f + ex));
    float g = -expf(lptr(p.in[11])[(l * 2 + dir) * 4 + h]) * sp;
    float cs = g;
#pragma unroll
    for (int o = 1; o < 64; o <<= 1) {
      float n = __shfl_up(cs, o, 64);
      if (lane >= o) cs += n;
    }
    cumL[t] = cs;
    betL[t] = beta;
    BAw[(size_t)row * 16 + 8 + dir * 4 + h] = cs;
  }
  if (item + (int)gridDim.x < 4352) ISSUE_T(item + (int)gridDim.x)
  LDS_SYNC();
  {
    const int fr = lane & 15, fq = lane >> 4;
    int tt = w >> 1;
#pragma unroll
    for (int u = 0; u < 2; ++u) {
      int st = (w & 1) * 2 + u;
      f32x4 a = f32x4{0.f, 0.f, 0.f, 0.f};
      if (st <= tt) {
#pragma unroll
        for (int k2 = 0; k2 < 4; ++k2)
          a = MFMA(ldfrag(ks, st * 16 + fr, 136, k2 * 32 + fq * 8), ldfrag(ks, tt * 16 + fr, 136, k2 * 32 + fq * 8), a);
      }
      int tau = tt * 16 + fr;
      float ct = cumL[tau], bt = betL[tau];
      f32x4 o;
#pragma unroll
      for (int r = 0; r < 4; ++r) {
        int sg = st * 16 + fq * 4 + r;
        o[r] = (sg < tau) ? bt * a[r] * __expf(ct - cumL[sg]) : 0.f;
      }
      *(f32x4*)(Am + tau * 68 + st * 16 + fq * 4) = o;
    }
  }
  LDS_SYNC();
  if (w < 4 && lane < 16) {
    const int I = w, cc = lane;
    float x[16];
#pragma unroll
    for (int i = 0; i < 16; ++i) {
      const f32x4* ap = (const f32x4*)(Am + (16 * I + i) * 68 + 16 * I);
      f32x4 a0 = ap[0], a1 = ap[1], a2 = ap[2], a3 = ap[3];
      const float aa[16] = {a0[0], a0[1], a0[2], a0[3], a1[0], a1[1], a1[2], a1[3], a2[0], a2[1], a2[2], a2[3], a3[0], a3[1], a3[2], a3[3]};
      float sacc = (i == cc) ? 1.f : 0.f;
#pragma unroll
      for (int ip = 0; ip < 16; ++ip)
        if (ip < i) sacc -= aa[ip] * x[ip];
      x[i] = sacc;
      Tm[(16 * I + i) * 68 + 16 * I + cc] = sacc;
    }
  }
  LDS_SYNC();
#pragma unroll 1
  for (int I = 1; I < 4; ++I) {
    for (int o = t; o < 256 * I; o += NT) {
      const int i = o & 15, cc = o >> 4;
      float sacc = 0.f;
      const float* arow = Am + (16 * I + i) * 68;
#pragma unroll 16
      for (int sg = 0; sg < 16 * I; ++sg) sacc += arow[sg] * Tm[sg * 68 + cc];
      Wm[i * 68 + cc] = sacc;
    }
    LDS_SYNC();
    for (int o = t; o < 256 * I; o += NT) {
      const int i = o & 15, cc = o >> 4;
      float sacc = 0.f;
      const float* trow = Tm + (16 * I + i) * 68 + 16 * I;
#pragma unroll
      for (int ip = 0; ip < 16; ++ip) sacc -= trow[ip] * Wm[ip * 68 + cc];
      Tm[(16 * I + i) * 68 + cc] = sacc;
    }
    LDS_SYNC();
  }
  {
    int tau = t >> 3, s0 = (t & 7) * 8;
    int row = chain_row(b, dir, c, tau);
    const float* tr = Tm + tau * 68 + s0;
    u32x4 o, ow;
#pragma unroll
    for (int i = 0; i < 4; ++i) {
      float x0 = tr[2 * i] * betL[s0 + 2 * i], x1 = tr[2 * i + 1] * betL[s0 + 2 * i + 1];
      o[i] = pack2(x0, x1);
      ow[i] = pack2(x0 * __expf(cumL[s0 + 2 * i]), x1 * __expf(cumL[s0 + 2 * i + 1]));
    }
    *(u32x4*)(PB + (size_t)row * 2304 + h * 128 + dir * 64 + s0) = o;
    *(u32x4*)((u16*)(lptr(p.ws) + OFF_NA) + (size_t)row * 1536 + 512 + h * 128 + dir * 64 + s0) = ow;
  }
  }
#undef ISSUE_T
}

__device__ __forceinline__ void chain_b(const P& p, int l, int item, char* smem) {
  const int t = TID(), lane = t & 63, w = t >> 6;
  const int vs = (item >> 3) & 3, chn = ((item >> 5) << 3) | (item & 7), dir = chn & 1, h = (chn >> 1) & 3, b = chn >> 3;
  u16* qs = (u16*)smem;
  u16* ks = qs + 64 * 136;
  u16* wl = ks + 64 * 136;
  u16* kT = wl + 64 * 136;
  u16* Tu = kT + 128 * 72;
  u16* Tw = Tu + 64 * 72;
  u16* at = Tw + 64 * 72;
  u16* vT = at + 64 * 72;
  u16* vnT = vT + 32 * 72;
  u16* vnsT = vnT + 32 * 72;
  u16* sT = vnsT + 32 * 72;
  float* cumL = (float*)(sT + 32 * 136);
  float* ecum = cumL + 64;
  float* elc = ecum + 64;
  float* misc = elc + 64;
  const u16* Q = (const u16*)(lptr(p.ws) + OFF_R + R_QKV);
  u16* PB = (u16*)(lptr(p.ws) + OFF_R + R_PB);
  const int fr = lane & 15, fq = lane >> 4;
  f32x4 S[2];
  S[0] = f32x4{0.f, 0.f, 0.f, 0.f};
  S[1] = S[0];
  u32x4 pq0, pq1, pk0, pk1, ptv, ptw;
  unsigned pv0, pv1;
  float pa = 0.f;
  const u16* NXp = (const u16*)(lptr(p.ws) + OFF_NA);
  const float* BAp = (const float*)(lptr(p.ws) + OFF_BA);
#define ISSUE_B(cc)                                                                               \
  {                                                                                               \
    int row = chain_row(b, dir, (cc), t & 63);                                                    \
    const u16* sq = Q + (size_t)row * 1536 + h * 128 + (t >> 6) * 16;                             \
    pq0 = *(const u32x4*)sq; pq1 = *(const u32x4*)(sq + 8);                                       \
    pk0 = *(const u32x4*)(sq + 512); pk1 = *(const u32x4*)(sq + 520);                             \
    const unsigned* vp = (const unsigned*)(Q + (size_t)row * 1536 + 1024 + h * 128 + vs * 32 + (t >> 6) * 4); \
    pv0 = vp[0]; pv1 = vp[1];                                                                     \
    int rowT = chain_row(b, dir, (cc), t >> 3);                                                   \
    ptv = *(const u32x4*)(PB + (size_t)rowT * 2304 + h * 128 + dir * 64 + (t & 7) * 8);           \
    ptw = *(const u32x4*)(NXp + (size_t)rowT * 1536 + 512 + h * 128 + dir * 64 + (t & 7) * 8);    \
    if (t < 64) {                                                                                 \
      int rowt = chain_row(b, dir, (cc), t);                                                      \
      pa = BAp[(size_t)rowt * 16 + 8 + dir * 4 + h];                                              \
    }                                                                                             \
  }
  ISSUE_B(0)
  for (int c = 0; c < 68; ++c) {
    LDS_SYNC();
    {
      int tauT = t >> 3, s0 = (t & 7) * 8;
      *(u32x4*)(Tu + tauT * 72 + s0) = ptv;
      *(u32x4*)(Tw + tauT * 72 + s0) = ptw;
    }
    {
      int tau = t & 63, d0 = (t >> 6) * 16;
      *(u32x4*)(qs + tau * 136 + d0) = pq0;
      *(u32x4*)(qs + tau * 136 + d0 + 8) = pq1;
      *(u32x4*)(ks + tau * 136 + d0) = pk0;
      *(u32x4*)(ks + tau * 136 + d0 + 8) = pk1;
#pragma unroll
      for (int i = 0; i < 4; ++i) {
        kT[(d0 + 2 * i) * 72 + tau] = (u16)(pk0[i] & 0xffff);
        kT[(d0 + 2 * i + 1) * 72 + tau] = (u16)(pk0[i] >> 16);
        kT[(d0 + 8 + 2 * i) * 72 + tau] = (u16)(pk1[i] & 0xffff);
        kT[(d0 + 8 + 2 * i + 1) * 72 + tau] = (u16)(pk1[i] >> 16);
      }
      int v4 = (t >> 6) * 4;
      vT[(v4 + 0) * 72 + tau] = (u16)(pv0 & 0xffff);
      vT[(v4 + 1) * 72 + tau] = (u16)(pv0 >> 16);
      vT[(v4 + 2) * 72 + tau] = (u16)(pv1 & 0xffff);
      vT[(v4 + 3) * 72 + tau] = (u16)(pv1 >> 16);
    }
    if (t < 64) {
      float cs = pa;
      float last = __shfl(cs, 63, 64);
      cumL[t] = cs;
      ecum[t] = __expf(cs);
      elc[t] = __expf(last - cs);
      if (t == 0) misc[0] = __expf(last);
    }
#pragma unroll
    for (int vt = 0; vt < 2; ++vt) *(uint2*)(sT + (vt * 16 + fr) * 136 + w * 16 + fq * 4) = pack4(S[vt]);
    if (c + 1 < 68) ISSUE_B(c + 1)
    LDS_SYNC();
    const int vt = w & 1, tt = w >> 1;
    f32x4 au = f32x4{0.f, 0.f, 0.f, 0.f};
    bf16x8 kfr[2], sfr[4];
    {
#pragma unroll
      for (int u = 0; u < 2; ++u) {
        int st = (w & 1) * 2 + u;
        f32x4 a = f32x4{0.f, 0.f, 0.f, 0.f};
        if (st <= tt) {
#pragma unroll
          for (int k2 = 0; k2 < 4; ++k2)
            a = MFMA(ldfrag(ks, st * 16 + fr, 136, k2 * 32 + fq * 8), ldfrag(qs, tt * 16 + fr, 136, k2 * 32 + fq * 8), a);
          int tau = tt * 16 + fr;
          float ct = cumL[tau];
#pragma unroll
          for (int r = 0; r < 4; ++r) {
            int sg = st * 16 + fq * 4 + r;
            a[r] = (sg <= tau) ? a[r] * __expf(ct - cumL[sg]) : 0.f;
          }
        }
        *(uint2*)(at + (tt * 16 + fr) * 72 + st * 16 + fq * 4) = pack4(a);
      }
#pragma unroll
      for (int k2 = 0; k2 < 2; ++k2)
        au = MFMA(ldfrag(vT, vt * 16 + fr, 72, k2 * 32 + fq * 8), ldfrag(Tu, tt * 16 + fr, 72, k2 * 32 + fq * 8), au);
      kfr[0] = ldfrag(kT, w * 16 + fr, 72, fq * 8);
      kfr[1] = ldfrag(kT, w * 16 + fr, 72, 32 + fq * 8);
#pragma unroll
      for (int t2 = 0; t2 < 4; ++t2) {
        f32x4 a = f32x4{0.f, 0.f, 0.f, 0.f};
#pragma unroll
        for (int k2 = 0; k2 < 2; ++k2)
          a = MFMA(kfr[k2], ldfrag(Tw, t2 * 16 + fr, 72, k2 * 32 + fq * 8), a);
        *(uint2*)(wl + (t2 * 16 + fr) * 136 + w * 16 + fq * 4) = pack4(a);
      }
    }
    LDS_SYNC();
    {
      f32x4 a = f32x4{0.f, 0.f, 0.f, 0.f};
#pragma unroll
      for (int k2 = 0; k2 < 4; ++k2) {
        sfr[k2] = ldfrag(sT, vt * 16 + fr, 136, k2 * 32 + fq * 8);
        a = MFMA(sfr[k2], ldfrag(wl, tt * 16 + fr, 136, k2 * 32 + fq * 8), a);
      }
      int tau = tt * 16 + fr;
      float el = elc[tau];
#pragma unroll
      for (int r = 0; r < 4; ++r) {
        float vn = au[r] - a[r];
        int vv = vt * 16 + fq * 4 + r;
        vnT[vv * 72 + tau] = f2bf(vn);
        vnsT[vv * 72 + tau] = f2bf(vn * el);
      }
    }
    LDS_SYNC();
    {
      f32x4 a1 = f32x4{0.f, 0.f, 0.f, 0.f}, a2 = f32x4{0.f, 0.f, 0.f, 0.f};
#pragma unroll
      for (int k2 = 0; k2 < 4; ++k2)
        a1 = MFMA(sfr[k2], ldfrag(qs, tt * 16 + fr, 136, k2 * 32 + fq * 8), a1);
#pragma unroll
      for (int k2 = 0; k2 < 2; ++k2)
        a2 = MFMA(ldfrag(vnT, vt * 16 + fr, 72, k2 * 32 + fq * 8), ldfrag(at, tt * 16 + fr, 72, k2 * 32 + fq * 8), a2);
      int tau = tt * 16 + fr;
      float ec = ecum[tau];
      f32x4 o;
#pragma unroll
      for (int r = 0; r < 4; ++r) o[r] = ec * a1[r] + a2[r];
      int row = chain_row(b, dir, c, tau);
      *(uint2*)(PB + (size_t)row * 2304 + 512 + dir * 512 + h * 128 + vs * 32 + vt * 16 + fq * 4) = pack4(o);
      float elast = misc[0];
#pragma unroll
      for (int v2 = 0; v2 < 2; ++v2) {
        f32x4 ds = f32x4{0.f, 0.f, 0.f, 0.f};
#pragma unroll
        for (int k2 = 0; k2 < 2; ++k2)
          ds = MFMA(kfr[k2], ldfrag(vnsT, v2 * 16 + fr, 72, k2 * 32 + fq * 8), ds);
#pragma unroll
        for (int r = 0; r < 4; ++r) S[v2][r] = elast * S[v2][r] + ds[r];
      }
    }
  }
}
#undef ISSUE_B

__device__ __forceinline__ void s5_tables(const P& p, int l, int item, char* smem) {
  const int t = TID();
  char* R = lptr(p.ws) + OFF_R;
  if (item < 512) {
    const int g = item >> 4, tb = item & 15;
    float2* pw = (float2*)smem;
    float2* Cc = pw + 512;
    __syncthreads();
    {
      int tl = t >> 7, dirx = (t >> 6) & 1, s0 = t & 63;
      int tau = tb * 4 + tl;
      S5c c = s5_load(p, l, dirx, g, s0);
      float pr, pi;
      s5_pow(c, dirx == 0 ? tau + 1 : 64 - tau, pr, pi);
      pw[t] = float2{pr, pi};
    }
    for (int e = t; e < 1024; e += NT) {
      int co = e >> 6, s2 = e & 63;
      Cc[e] = float2{lptr(p.in[19])[((size_t)(l * 32 + g) * 16 + co) * 64 + s2], lptr(p.in[20])[((size_t)(l * 32 + g) * 16 + co) * 64 + s2]};
    }
    __syncthreads();
    const float* KT = (const float*)(lptr(p.ws) + OFF_KT);
    u16* BP = (u16*)(R + R_BP);
    const int k = 2 * t, sg = k >> 4, ci = k & 15;
#pragma unroll 1
    for (int tl = 0; tl < 4; ++tl) {
      const int tau = tb * 4 + tl;
#pragma unroll 8
      for (int co = 0; co < 16; ++co) {
        float v0 = 0.f, v1 = 0.f;
        if (sg <= tau) { float2 a = *(const float2*)(KT + ((size_t)((0 * 32 + g) * 64 + (tau - sg))) * 256 + co * 16 + ci); v0 += a.x; v1 += a.y; }
        if (sg >= tau) { float2 a = *(const float2*)(KT + ((size_t)((1 * 32 + g) * 64 + (sg - tau))) * 256 + co * 16 + ci); v0 += a.x; v1 += a.y; }
        if (sg == tau) { float dsk = lptr(p.in[21])[l * 512 + g * 16 + co]; if (co == ci) v0 += dsk; if (co == ci + 1) v1 += dsk; }
        u16* rowp = BP + ((size_t)(g * 1024 + tau * 16 + co)) * 1280;
        *(unsigned*)(rowp + k) = pack2(v0, v1);
        if (t < 128) {
          int kk = 2 * t;
          int dirx = kk >> 7, si = kk & 127, s2 = si & 63, isim = si >> 6;
          float2 cA = Cc[co * 64 + s2], cB = Cc[co * 64 + s2 + 1];
          float2 pA = pw[(tl * 2 + dirx) * 64 + s2], pB = pw[(tl * 2 + dirx) * 64 + s2 + 1];
          float reA = cA.x * pA.x - cA.y * pA.y, imA = cA.x * pA.y + cA.y * pA.x;
          float reB = cB.x * pB.x - cB.y * pB.y, imB = cB.x * pB.y + cB.y * pB.x;
          *(unsigned*)(rowp + 1024 + kk) = isim ? pack2(-imA, -imB) : pack2(reA, reB);
        }
      }
    }
  } else {
    item -= 512;
    const int sb = item & 7, g = (item >> 3) & 31, dir = item >> 8;
    float2* pc = (float2*)smem;
    __syncthreads();
    {
      int sl = t >> 6, s0 = t & 63;
      int sg = sb * 8 + sl;
      S5c c = s5_load(p, l, dir, g, s0);
      float pr, pi, cr, ci;
      s5_pow(c, dir == 0 ? 63 - sg : sg, pr, pi);
      s5_coef(c, cr, ci);
      pc[t] = float2{pr * cr - pi * ci, pr * ci + pi * cr};
    }
    __syncthreads();
    u16* M1 = (u16*)(R + R_M1);
    const float* bre = lptr(p.in[17]) + (size_t)(l * 32 + g) * 1024;
    const float* bim = lptr(p.in[18]) + (size_t)(l * 32 + g) * 1024;
#pragma unroll 8
    for (int e = t; e < 16384; e += NT) {
      int n = e >> 7, kk = e & 127, sl = kk >> 4, ci2 = kk & 15;
      int s0 = n & 63, isim = n >> 6;
      float br = bre[s0 * 16 + ci2], bi = bim[s0 * 16 + ci2];
      float2 q = pc[sl * 64 + s0];
      float v = isim ? (q.x * bi + q.y * br) : (q.x * br - q.y * bi);
      M1[((size_t)((dir * 32 + g) * 128 + n)) * 1024 + sb * 128 + kk] = f2bf(v);
    }
  }
}

__device__ __forceinline__ void s5_state(const P& p, int tile, char* smem) {
  char* R = lptr(p.ws) + OFF_R;
  const int dg = tile / 3, tm = tile % 3;
  const int g = dg & 31;
  f32x4 acc[4][4];
  zero_acc(acc);
  gemm_loop((const u16*)(R + R_UG) + ((size_t)(g * 768 + tm * 256)) * 1280, 1280,
            (const u16*)(R + R_M1) + (size_t)dg * 128 * 1024, 1024, 1024, smem, acc);
  float* DS = (float*)(R + R_DS);
  EPI_LOOP({
    int chunk = tm * 256 + ml;
    if (chunk < 544) *(float4*)(DS + ((size_t)(dg * 768 + chunk)) * 128 + nl) = float4{v[0], v[1], v[2], v[3]};
  })
}

__device__ __forceinline__ void s5_scan(const P& p, int l, int item) {
  const int id = item * NT + TID();
  const int s = id & 63, g = (id >> 6) & 31, dir = (id >> 11) & 1, b = id >> 12;
  char* R = lptr(p.ws) + OFF_R;
  S5c c = s5_load(p, l, dir, g, s);
  float a_r, a_i;
  s5_pow(c, 64, a_r, a_i);
  const float* DS = (const float*)(R + R_DS);
  u16* UG = (u16*)(R + R_UG);
  float xr = 0.f, xi = 0.f;
#pragma unroll 1
  for (int bt = 0; bt < 4; ++bt) {
    float dr[17], di[17];
#pragma unroll
    for (int i = 0; i < 17; ++i) {
      int step = bt * 17 + i;
      int c68 = dir == 0 ? step : (step < 4 ? 3 - step : 71 - step);
      const float* dp = DS + ((size_t)((dir * 32 + g) * 768 + b * 68 + c68)) * 128;
      dr[i] = dp[s];
      di[i] = dp[64 + s];
    }
#pragma unroll
    for (int i = 0; i < 17; ++i) {
      int step = bt * 17 + i;
      int c68 = dir == 0 ? step : (step < 4 ? 3 - step : 71 - step);
      u16* up = UG + ((size_t)(g * 768 + b * 68 + c68)) * 1280 + 1024 + dir * 128;
      up[s] = f2bf(xr);
      up[64 + s] = f2bf(xi);
      float nr = a_r * xr - a_i * xi + dr[i];
      float ni = a_r * xi + a_i * xr + di[i];
      xr = nr;
      xi = ni;
    }
  }
}

__device__ __forceinline__ void final_norm(const P& p, int item) {
  const int t = TID(), lane = t & 63, w = t >> 6;
  const int r = item * 8 + w;
  float* xr = lptr(p.out) + (size_t)r * 1024;
  float4 v[4];
  float ss = 0.f;
#pragma unroll
  for (int i = 0; i < 4; ++i) {
    v[i] = *(const float4*)(xr + i * 256 + lane * 4);
    ss += v[i].x * v[i].x + v[i].y * v[i].y + v[i].z * v[i].z + v[i].w * v[i].w;
  }
  ss = wsum(ss);
  float rstd = rsqrtf(ss * (1.f / 1024.f) + 1e-6f);
#pragma unroll
  for (int i = 0; i < 4; ++i) {
    int c = i * 256 + lane * 4;
    float4 wv = *(const float4*)(lptr(p.in[30]) + c);
    float4 o{v[i].x * rstd * wv.x, v[i].y * rstd * wv.y, v[i].z * rstd * wv.z, v[i].w * rstd * wv.w};
    *(float4*)(xr + c) = o;
  }
}

struct OrderStatic {
  int nM, nN, nwg, G, c;
  __device__ void init(int M, int N, int G_, int c_) { nM = M / 256; nN = N / 256; nwg = nM * nN; G = G_; c = c_; }
  __device__ bool next(int i, pg8::Unit& u) const {
    const long L = (long)i * G + c;
    if (L >= nwg) return false;
    int wgid = (int)L;
    { const int q = nwg / 8, r = nwg % 8, xcd = wgid % 8, off = wgid / 8; wgid = (xcd < r ? xcd * (q + 1) : r * (q + 1) + (xcd - r) * q) + off; }
    const int nig = 8 * nN, gid = wgid / nig, fm = gid * 8, gsz = (nM - fm) < 8 ? (nM - fm) : 8;
    u.pm = fm + ((wgid % nig) % gsz);
    u.pn = (wgid % nig) / gsz;
    return true;
  }
  __device__ __forceinline__ void a_ready(const pg8::Unit&) const {}
  __device__ __forceinline__ void done(const pg8::Unit&) const {}
};
struct OrderS5 {
  int G, c;
  __device__ bool next(int i, pg8::Unit& u) const {
    int L = i * G + c;
    if (L >= 384) return false;
    int g = L / 12, rem = L % 12;
    u.pm = g * 3 + (rem >> 2);
    u.pn = g * 4 + (rem & 3);
    return true;
  }
  __device__ __forceinline__ void a_ready(const pg8::Unit&) const {}
  __device__ __forceinline__ void done(const pg8::Unit&) const {}
};

#define PG_EPI_LOOP(...)                                                                   \
  _Pragma("unroll") for (int ai = 0; ai < 2; ++ai)                                         \
  _Pragma("unroll") for (int m = 0; m < 4; ++m)                                            \
  _Pragma("unroll") for (int bj = 0; bj < 2; ++bj)                                         \
  _Pragma("unroll") for (int n = 0; n < 2; ++n) {                                          \
    const int row = u.pm * 256 + ai * 128 + wr * 64 + m * 16 + fr;                         \
    const int col = u.pn * 256 + bj * 128 + wc * 32 + n * 16 + 4 * fq;                     \
    f32x4 v = acc[ai][bj][m][n];                                                           \
    __VA_ARGS__                                                                            \
  }
#define PG_EPI_LOOP8(...)                                                                  \
  _Pragma("unroll") for (int ai = 0; ai < 2; ++ai)                                         \
  _Pragma("unroll") for (int m = 0; m < 4; ++m)                                            \
  _Pragma("unroll") for (int bj = 0; bj < 2; ++bj) {                                       \
    const int row = u.pm * 256 + ai * 128 + wr * 64 + m * 16 + fr;                         \
    const int col = u.pn * 256 + bj * 128 + wc * 32 + 8 * fq;                              \
    f32x4 v0 = acc[ai][bj][m][0], v1 = acc[ai][bj][m][1];                                  \
    __VA_ARGS__                                                                            \
  }
__device__ __forceinline__ u32x4 pack8(f32x4 a, f32x4 b) { uint2 p0 = pack4(a), p1 = pack4(b); u32x4 r; r[0] = p0.x; r[1] = p0.y; r[2] = p1.x; r[3] = p1.y; return r; }
__device__ __forceinline__ void unpack8(u32x4 g, f32x4& a, f32x4& b) {
  a[0] = bf2f((u16)(g[0] & 0xffff)); a[1] = bf2f((u16)(g[0] >> 16)); a[2] = bf2f((u16)(g[1] & 0xffff)); a[3] = bf2f((u16)(g[1] >> 16));
  b[0] = bf2f((u16)(g[2] & 0xffff)); b[1] = bf2f((u16)(g[2] >> 16)); b[2] = bf2f((u16)(g[3] & 0xffff)); b[3] = bf2f((u16)(g[3] >> 16));
}
#define PG_EPI_SIG const f32x4 (&acc)[2][2][4][2], const pg8::Unit& u, int wr, int wc, int fr, int fq

template <int MODE> struct EpiStore {
  static constexpr bool PERM = true, AFTER_DRAIN = false, RESCALE = false;
  u16* C; int ldc; float* BA;
  __device__ __forceinline__ void operator()(PG_EPI_SIG) const {
    _Pragma("unroll") for (int ai = 0; ai < 2; ++ai)
    _Pragma("unroll") for (int m = 0; m < 4; ++m)
    _Pragma("unroll") for (int bj = 0; bj < 2; ++bj) {
      const int row = u.pm * 256 + ai * 128 + wr * 64 + m * 16 + fr;
      const int col = u.pn * 256 + bj * 128 + wc * 32 + 8 * fq;
      f32x4 v0 = acc[ai][bj][m][0], v1 = acc[ai][bj][m][1];
      f32x4 o0 = v0, o1 = v1;
      if (MODE == 3) { _Pragma("unroll") for (int r = 0; r < 4; ++r) { o0[r] = sigm(v0[r]); o1[r] = sigm(v1[r]); } }
      if (MODE == 4) { _Pragma("unroll") for (int r = 0; r < 4; ++r) { float x = fmaxf(v0[r], 0.f); o0[r] = x * x; float y = fmaxf(v1[r], 0.f); o1[r] = y * y; } }
      uint2 p0 = pack4(o0), p1 = pack4(o1);
      u32x4 pk; pk[0] = p0.x; pk[1] = p0.y; pk[2] = p1.x; pk[3] = p1.y;
      *(u32x4*)(C + (size_t)row * ldc + col) = pk;
      if (MODE == 1) {
        if (col >= 2048 && col < 2064) {
          float* bp = BA + (size_t)row * 16 + (col - 2048);
          *(f32x4*)bp = v0;
          *(f32x4*)(bp + 4) = v1;
        }
      }
    }
  }
};
struct EpiUg {
  static constexpr bool PERM = true, AFTER_DRAIN = false, RESCALE = false;
  u16* UG;
  __device__ __forceinline__ void operator()(PG_EPI_SIG) const {
    PG_EPI_LOOP8({
      int chunk, tau;
      if (row < MLAT) { int b = row >> 12, tt = row & 4095; chunk = b * 68 + 4 + (tt & 63); tau = tt >> 6; }
      else { int mm = row - MLAT; int b = mm >> 8, jj = mm & 255; chunk = b * 68 + (jj >> 6); tau = jj & 63; }
      int g = col >> 4, ci = col & 15;
      *(u32x4*)(UG + ((size_t)(g * 768 + chunk)) * 1280 + tau * 16 + ci) = pack8(v0, v1);
    })
  }
};
struct EpiGlu {
  static constexpr bool PERM = true, AFTER_DRAIN = false, RESCALE = false;
  const u16* ZC; u16* GL;
  __device__ __forceinline__ void operator()(PG_EPI_SIG) const {
    const int rowb = u.pm * 256 + wr * 64 + fr;
    const int colb = u.pn * 256 + wc * 32 + 8 * fq;
    _Pragma("unroll") for (int ai = 0; ai < 2; ++ai) {
      u32x4 z[4][2];
      _Pragma("unroll") for (int m = 0; m < 4; ++m)
      _Pragma("unroll") for (int bj = 0; bj < 2; ++bj)
        z[m][bj] = *(const u32x4*)(ZC + (size_t)(rowb + ai * 128 + m * 16) * 512 + colb + bj * 128);
      _Pragma("unroll") for (int m = 0; m < 4; ++m)
      _Pragma("unroll") for (int bj = 0; bj < 2; ++bj) {
        f32x4 z0, z1;
        unpack8(z[m][bj], z0, z1);
        f32x4 v0 = acc[ai][bj][m][0], v1 = acc[ai][bj][m][1];
        _Pragma("unroll") for (int r = 0; r < 4; ++r) { z0[r] *= sigm(v0[r]); z1[r] *= sigm(v1[r]); }
        *(u32x4*)(GL + (size_t)(rowb + ai * 128 + m * 16) * 1536 + colb + bj * 128) = pack8(z0, z1);
      }
    }
  }
};
struct EpiMix {
  static constexpr bool PERM = true, AFTER_DRAIN = false, RESCALE = true;
  const u16* PG; u16* MIX;
  __device__ __forceinline__ void rescale(f32x4 (&acc)[2][2][4][2], const pg8::Unit& u, int wr, int wc, int fr, int fq, int nb) const {
    int frl = fr;
    asm volatile("" : "+v"(frl));
    const unsigned base = (unsigned)((u.pm * 256 + wr * 64 + frl) * 3072 + u.pn * 256 + wc * 32 + 8 * fq + (nb - 1) * 1024);
    const u16* pgb = lptr(PG);
    _Pragma("unroll") for (int ai = 0; ai < 2; ++ai) {
      u32x4 ga[4][2], gb[4][2];
      _Pragma("unroll") for (int m = 0; m < 4; ++m)
      _Pragma("unroll") for (int bj = 0; bj < 2; ++bj) {
        const unsigned off = base + (unsigned)((ai * 128 + m * 16) * 3072 + bj * 128);
        ga[m][bj] = *(const u32x4*)(pgb + off);
        gb[m][bj] = *(const u32x4*)(pgb + off + 1024);
      }
      _Pragma("unroll") for (int m = 0; m < 4; ++m)
      _Pragma("unroll") for (int bj = 0; bj < 2; ++bj) {
        f32x4 a0, a1, b0, b1;
        unpack8(ga[m][bj], a0, a1);
        unpack8(gb[m][bj], b0, b1);
        f32x4 v0 = acc[ai][bj][m][0], v1 = acc[ai][bj][m][1];
        _Pragma("unroll") for (int r = 0; r < 4; ++r) {
          v0[r] *= a0[r] * __builtin_amdgcn_rcpf(fmaxf(b0[r], 1e-20f));
          v1[r] *= a1[r] * __builtin_amdgcn_rcpf(fmaxf(b1[r], 1e-20f));
        }
        acc[ai][bj][m][0] = v0;
        acc[ai][bj][m][1] = v1;
      }
      __builtin_amdgcn_sched_barrier(0);
    }
  }
  __device__ __forceinline__ void operator()(PG_EPI_SIG) const {
    const int rowb = u.pm * 256 + wr * 64 + fr;
    const int colb = u.pn * 256 + wc * 32 + 8 * fq;
    _Pragma("unroll") for (int ai = 0; ai < 2; ++ai) {
      u32x4 gq[4][2];
      _Pragma("unroll") for (int m = 0; m < 4; ++m)
      _Pragma("unroll") for (int bj = 0; bj < 2; ++bj)
        gq[m][bj] = *(const u32x4*)(PG + (size_t)(rowb + ai * 128 + m * 16) * 3072 + 2048 + colb + bj * 128);
      _Pragma("unroll") for (int m = 0; m < 4; ++m)
      _Pragma("unroll") for (int bj = 0; bj < 2; ++bj) {
        f32x4 g0, g1;
        unpack8(gq[m][bj], g0, g1);
        f32x4 v0 = acc[ai][bj][m][0], v1 = acc[ai][bj][m][1];
        _Pragma("unroll") for (int r = 0; r < 4; ++r) { g0[r] *= v0[r]; g1[r] *= v1[r]; }
        *(u32x4*)(MIX + (size_t)(rowb + ai * 128 + m * 16) * 1024 + colb + bj * 128) = pack8(g0, g1);
      }
    }
  }
};
struct EpiRes {
  static constexpr bool PERM = true, AFTER_DRAIN = false, RESCALE = false;
  const float* xin; float* out; float* xc; const float* modsb;
  __device__ __forceinline__ void operator()(PG_EPI_SIG) const {
    const int rowb = u.pm * 256 + wr * 64 + fr;
    const int colb = u.pn * 256 + wc * 32 + 8 * fq;
    const bool lat = rowb < MLAT;
    const float* srcb = lat ? xin + (size_t)rowb * 1024 + colb : xc + (size_t)(rowb - MLAT) * 1024 + colb;
    float* dstb = lat ? out + (size_t)rowb * 1024 + colb : xc + (size_t)(rowb - MLAT) * 1024 + colb;
    const float* gp = modsb + (size_t)mod_idx(rowb) * 6144 + colb;
    f32x4 g[2][2];
    _Pragma("unroll") for (int bj = 0; bj < 2; ++bj) { g[bj][0] = *(const f32x4*)(gp + bj * 128); g[bj][1] = *(const f32x4*)(gp + bj * 128 + 4); }
    _Pragma("unroll") for (int ai = 0; ai < 2; ++ai) {
      f32x4 x[4][2][2];
      _Pragma("unroll") for (int m = 0; m < 4; ++m)
      _Pragma("unroll") for (int bj = 0; bj < 2; ++bj) {
        const float* sp = srcb + (size_t)(ai * 128 + m * 16) * 1024 + bj * 128;
        x[m][bj][0] = *(const f32x4*)sp;
        x[m][bj][1] = *(const f32x4*)(sp + 4);
      }
      _Pragma("unroll") for (int m = 0; m < 4; ++m)
      _Pragma("unroll") for (int bj = 0; bj < 2; ++bj) {
        float* dp = dstb + (size_t)(ai * 128 + m * 16) * 1024 + bj * 128;
        *(f32x4*)dp = x[m][bj][0] + g[bj][0] * acc[ai][bj][m][0];
        *(f32x4*)(dp + 4) = x[m][bj][1] + g[bj][1] * acc[ai][bj][m][1];
      }
    }
  }
};
struct EpiS5Out {
  static constexpr bool PERM = true, AFTER_DRAIN = false, RESCALE = false;
  u16* ZC;
  __device__ __forceinline__ void operator()(PG_EPI_SIG) const {
    const int g = u.pm / 3;
    PG_EPI_LOOP8({
      int chunk = row - g * 768;
      if (chunk < 544) {
        int nn = col - g * 1024;
        int tau = nn >> 4, co = nn & 15;
        int b = chunk / 68, c68 = chunk % 68;
        int orow = c68 < 4 ? MLAT + b * 256 + c68 * 64 + tau : b * 4096 + tau * 64 + (c68 - 4);
        f32x4 z0, z1;
        _Pragma("unroll") for (int r = 0; r < 4; ++r) { z0[r] = geluf(v0[r]); z1[r] = geluf(v1[r]); }
        *(u32x4*)(ZC + (size_t)orow * 512 + g * 16 + co) = pack8(z0, z1);
      }
    })
  }
};

template <class Epi>
__device__ __forceinline__ void run_gemm(const u16* A, const u16* Bt, int M, int N, int K, const Epi& E, char* smem, int crot = 0) {
  OrderStatic S;
  S.init(M, N, gridDim.x, (blockIdx.x + crot) % gridDim.x);
  pg8::Gemm g{A, Bt, M, N, K};
  __syncthreads();
  pg8::gemm_phase<Epi, OrderStatic, false>((PG8_LAS unsigned char*)smem, g, S, E, nullptr);
  __syncthreads();
}

__device__ __forceinline__ void gemm_simple(const P& p, int mode, char* smem, int M = MALL) {
  const u16* H = (const u16*)(lptr(p.ws) + OFF_H);
  const u16* WT = (const u16*)(lptr(p.ws) + OFF_WT);
  char* R = lptr(p.ws) + OFF_R;
  if (mode == 0) {
    EpiStore<0> E{(u16*)(R + R_PA), 2560, nullptr};
    run_gemm(H, WT + W_IN, MALL, 2560, 1024, E, smem);
  } else if (mode == 1) {
    EpiStore<1> E{(u16*)(R + R_PB), 2304, (float*)(lptr(p.ws) + OFF_BA)};
    run_gemm(H, WT + W_IN + (size_t)2560 * 1024, MALL, 2304, 1024, E, smem);
  } else if (mode == 2) {
    EpiUg E{(u16*)(R + R_UG)};
    run_gemm(H, WT + W_IN + (size_t)4864 * 1024, MALL, 512, 1024, E, smem);
  } else if (mode == 3) {
    EpiStore<3> E{(u16*)(R + R_PG), 3072, nullptr};
    run_gemm(H, WT + W_IN + (size_t)5376 * 1024, M, 3072, 1024, E, smem, 128);
  } else {
    EpiStore<4> E{(u16*)(R + R_HID), 4096, nullptr};
    run_gemm(H, WT + W_FF1, M, 4096, 1024, E, smem);
  }
}
__device__ __forceinline__ void s5_out(const P& p, char* smem) {
  char* R = lptr(p.ws) + OFF_R;
  OrderS5 S{(int)gridDim.x, (int)blockIdx.x};
  pg8::Gemm g{(const u16*)(R + R_UG), (const u16*)(R + R_BP), 32 * 768, 32 * 1024, 1280};
  EpiS5Out E{(u16*)(R + R_ZC)};
  __syncthreads();
  pg8::gemm_phase<EpiS5Out, OrderS5, false>((PG8_LAS unsigned char*)smem, g, S, E, nullptr);
  __syncthreads();
}
__device__ __forceinline__ void glu_gemm(const P& p, char* smem, int M) {
  char* R = lptr(p.ws) + OFF_R;
  EpiGlu E{(const u16*)(R + R_ZC), (u16*)(lptr(p.ws) + OFF_NA) + 1024};
  run_gemm((const u16*)(R + R_ZC), (const u16*)(lptr(p.ws) + OFF_WT) + W_GLU, M, 512, 512, E, smem);
}
__device__ __forceinline__ void mix_gemm(const P& p, char* smem, int M) {
  const u16* WT = (const u16*)(lptr(p.ws) + OFF_WT);
  EpiMix E{(const u16*)(lptr(p.ws) + OFF_R + R_PG), (u16*)(lptr(p.ws) + OFF_H)};
  run_gemm((const u16*)(lptr(p.ws) + OFF_NA), WT + W_BA, M, 1024, 1536, E, smem);
}
__device__ __forceinline__ void res_gemm(const P& p, int l, int which, char* smem, int M) {
  const u16* WT = (const u16*)(lptr(p.ws) + OFF_WT);
  EpiRes E;
  E.xin = (which == 0 && l == 0) ? lptr(p.in[0]) : lptr(p.out);
  E.out = lptr(p.out);
  E.xc = (float*)(lptr(p.ws) + OFF_XC);
  E.modsb = (const float*)(lptr(p.ws) + OFF_MODS) + (size_t)l * 9 * 6144 + (which == 0 ? 2 : 5) * 1024;
  if (which == 0) run_gemm((const u16*)(lptr(p.ws) + OFF_H), WT + W_O, M, 1024, 1024, E, smem);
  else run_gemm((const u16*)(lptr(p.ws) + OFF_R + R_HID), WT + W_FF2, M, 1024, 4096, E, smem);
}

#define XB_TMO      128
#define XB_XCNT(j)  (256  + 64 * (j))
#define XB_XSUB(j)  (1280 + 64 * (j))
#define XB_XGEN(j)  (2304 + 64 * (j))
#define XB_TOP      3328
#define XB_TOPGEN   3392
#define XCD_BAR_WORDS 3456
#define XB_SPIN_CAP (1u << 21)
#define LAS __attribute__((address_space(3)))

__device__ __forceinline__ unsigned xb_ld(unsigned* p)              { return __hip_atomic_load(p, __ATOMIC_RELAXED, __HIP_MEMORY_SCOPE_AGENT); }
__device__ __forceinline__ unsigned xb_add(unsigned* p, unsigned v) { return __hip_atomic_fetch_add(p, v, __ATOMIC_RELAXED, __HIP_MEMORY_SCOPE_AGENT); }
__device__ __forceinline__ unsigned xb_xcc_id() { return (unsigned)__builtin_amdgcn_s_getreg((3 << 11) | 20) & 0xFu; }
#define XB_SPIN(cond, bar) do { unsigned _sp = 0; while (cond) { __builtin_amdgcn_s_sleep(1); \
    if ((++_sp & 255u) == 0u) { if (xb_ld(&(bar)[XB_TMO])) break; if (_sp > XB_SPIN_CAP) { atomicAdd(&(bar)[XB_TMO], 1u); break; } } } } while (0)

struct XcdBarrier {
    unsigned* bar; unsigned x;
    volatile LAS unsigned* st;
};

__device__ __forceinline__ XcdBarrier xcd_barrier_post(unsigned* bar, volatile LAS unsigned* st) {
    XcdBarrier b; b.bar = bar; b.x = xb_xcc_id(); b.st = st;
    if (TID() == 0) (void)xb_add(&bar[XB_XCNT(b.x)], 1u);
    return b;
}
__device__ __forceinline__ void xcd_barrier_complete(unsigned* bar, unsigned x, unsigned& nloc, unsigned& nx) {
    const unsigned G = gridDim.x * gridDim.y * gridDim.z;
    unsigned sum, cnt, mine, sp = 0u;
    for (;;) {
        sum = 0u; cnt = 0u; mine = 0u;
#pragma unroll
        for (unsigned j = 0; j < 16; ++j) { const unsigned c = xb_ld(&bar[XB_XCNT(j)]); sum += c; cnt += (c > 0u) ? 1u : 0u; mine = (j == x) ? c : mine; }
        if (sum == G) break;
        __builtin_amdgcn_s_sleep(1);
        if ((++sp & 255u) == 0u) { if (xb_ld(&bar[XB_TMO])) break; if (sp > XB_SPIN_CAP) { atomicAdd(&bar[XB_TMO], 1u); break; } }
    }
    nloc = mine > 0u ? mine : 1u; nx = cnt > 0u ? cnt : 1u;
}

__device__ __forceinline__ void xcd_barrier(const XcdBarrier& b) {
    asm volatile("s_waitcnt vmcnt(0)" ::: "memory");
    __syncthreads();
    if (TID() == 0) {
        unsigned* bar = b.bar;
        __builtin_amdgcn_s_waitcnt(0);
        unsigned nloc = b.st[0], nx = b.st[1];
        if (nloc == 0u) { xcd_barrier_complete(bar, b.x, nloc, nx); b.st[0] = nloc; b.st[1] = nx; }
        const unsigned old = xb_add(&bar[XB_XSUB(b.x)], 1u);
        const unsigned gen = old / nloc;
        if (old + 1u == (gen + 1u) * nloc) {
            __builtin_amdgcn_fence(__ATOMIC_RELEASE, "agent");
            asm volatile("s_waitcnt vmcnt(0)" ::: "memory");
            const unsigned og = xb_add(&bar[XB_TOP], 1u);
            const unsigned tg = og / nx;
            if (og + 1u == (tg + 1u) * nx) xb_add(&bar[XB_TOPGEN], 1u);
            else XB_SPIN(xb_ld(&bar[XB_TOPGEN]) == tg, bar);
            __builtin_amdgcn_fence(__ATOMIC_ACQUIRE, "agent");
            xb_add(&bar[XB_XGEN(b.x)], 1u);
            asm volatile("s_waitcnt vmcnt(0)" ::: "memory");
        } else {
            XB_SPIN(xb_ld(&bar[XB_XGEN(b.x)]) == gen, bar);
            __builtin_amdgcn_fence(__ATOMIC_ACQUIRE, "agent");
            asm volatile("s_waitcnt vmcnt(0)" ::: "memory");
        }
    }
    __syncthreads();
}


#define NSUB 20
#ifndef PROBE_MASK
#define PROBE_MASK 0
#endif
#define NPHASE (1 + 2 * NSUB + 1)

__device__ __forceinline__ void run_phase(const P& p, int ph, char* smem) {
  const int bid = blockIdx.x, nb = gridDim.x;
  if (ph == 0) {
    for (int i = bid; i < 449 + 1216 + 512; i += nb) {
      if (i < 449) ph_init(p, i, smem);
      else if (i < 449 + 1216) ph_start(p, 0, i - 449, smem);
      else ph_start(p, 0, 3392 + (i - 449 - 1216), smem);
    }
    return;
  }
  if (ph == NPHASE - 1) { for (int i = bid; i < 4096; i += nb) final_norm(p, i); return; }
  const int l = (ph - 1) / NSUB, sub = (ph - 1) % NSUB;
  const int Mr = (l == 1) ? MLAT : MALL;
  switch (sub) {
    case 0:
      if (l == 0) { for (int i = 1216 + bid; i < 1216 + 2176; i += nb) ph_start(p, l, i, smem); }
      else { for (int i = bid; i < 1216 + 2176 + 512; i += nb) ph_start(p, l, i, smem); }
      break;
    case 1: gemm_simple(p, 0, smem); break;
    case 2: prep_a(p, l, smem); break;
    case 3: for (int i = bid; i < 256; i += nb) chain_a(p, l, i, smem); break;
    case 4: for (int i = bid; i < 2176; i += nb) normgate(p, l, i, 0); break;
    case 5: gemm_simple(p, 1, smem); break;
    case 6: for (int i = bid; i < 3264; i += nb) conv_b(p, l, i); break;
    case 7: tphase_b(p, l, smem); break;
    case 8: for (int i = bid; i < 256; i += nb) chain_b(p, l, i, smem); break;
    case 9: for (int i = bid; i < 2176; i += nb) normgate(p, l, i, 1); break;
    case 10:
      gemm_simple(p, 2, smem);
      for (int i = bid; i < 1024; i += nb) s5_tables(p, l, i, smem);
      break;
    case 11: for (int i = bid; i < 192; i += nb) s5_state(p, i, smem); break;
    case 12: for (int i = bid; i < 64; i += nb) s5_scan(p, l, i); break;
    case 13: s5_out(p, smem); break;
    case 14:
      glu_gemm(p, smem, Mr);
      gemm_simple(p, 3, smem, Mr);
      break;
    case 15: mix_gemm(p, smem, Mr); break;
    case 16: res_gemm(p, l, 0, smem, Mr); break;
    case 17: for (int i = bid; i < Mr / 16; i += nb) norm_rows(p, l, i, 1); break;
    case 18: gemm_simple(p, 4, smem, Mr); break;
    case 19: res_gemm(p, l, 1, smem, Mr); break;
  }
}

__global__ void __launch_bounds__(NT) mega(P p, int ph_lo, int ph_hi) {
  extern __shared__ __attribute__((aligned(16))) char smem[];
  cg::grid_group grid = cg::this_grid();
  unsigned* stw = (unsigned*)(smem + 131072);
  if (threadIdx.x == 0) { stw[0] = 0u; stw[1] = 0u; stw[2] = 0u; stw[3] = 0u; }
  __syncthreads();
  XcdBarrier xb;
  if (ph_hi - ph_lo > 1) xb = xcd_barrier_post((unsigned*)(p.ws + OFF_BAR), (volatile LAS unsigned*)stw);
  for (int ph = ph_lo; ph < ph_hi; ++ph) {
    run_phase(p, ph, smem);
    if (PROBE_MASK != 0 && ph > 0 && ph < NPHASE - 1 && ((PROBE_MASK >> ((ph - 1) % NSUB)) & 1)) { __syncthreads(); run_phase(p, ph, smem); }
    if (ph + 1 < ph_hi) { if (ph == ph_lo) grid.sync(); else xcd_barrier(xb); }
  }
}

extern "C" void kernel_launch(void* const* d_in, const int* in_sizes, int n_in, void* d_out, int out_size, void* d_ws,
                              size_t ws_size, hipStream_t stream) {
  static int grid_blocks = 0;
  if (!grid_blocks) {
    hipFuncSetAttribute((const void*)mega, hipFuncAttributeMaxDynamicSharedMemorySize, LDS_BYTES);
    int dev = 0, cus = 0, per_cu = 0;
    hipGetDevice(&dev);
    hipDeviceGetAttribute(&cus, hipDeviceAttributeMultiprocessorCount, dev);
    hipOccupancyMaxActiveBlocksPerMultiprocessor(&per_cu, mega, NT, LDS_BYTES);
    if (per_cu < 1) per_cu = 1;
    grid_blocks = cus * per_cu;
  }
  P p{};
  for (int i = 0; i < 31; ++i) p.in[i] = (const float*)d_in[i];
  p.out = (float*)d_out;
  p.ws = (char*)d_ws;
#if COOP
  hipMemsetAsync((char*)d_ws + OFF_BAR, 0, XCD_BAR_WORDS * 4, stream);
  int lo = 0, hi = NPHASE;
  void* args[] = {&p, &lo, &hi};
  hipError_t e = hipLaunchCooperativeKernel((void*)mega, dim3(grid_blocks), dim3(NT), args, LDS_BYTES, stream);
  if (e != hipSuccess) fprintf(stderr, "cooperative launch failed: %s (grid %d)\n", hipGetErrorString(e), grid_blocks);
#else
  for (int ph = 0; ph < NPHASE; ++ph) mega<<<grid_blocks, NT, LDS_BYTES, stream>>>(p, ph, ph + 1);
#endif
}
```
